# Optimizing an MI355X kernel written in HIP

```python
import math
import jax, jax.numpy as jnp
from jax import lax
import numpy as np

D_MODEL = 2048
BATCH = 1
SEQ = 8192
DEPTH = 1

HEAD_DIM = 128
MIX_WIDTH = D_MODEL
FOURIER_WIDTH = MIX_WIDTH // 4
ATTN_WIDTH = MIX_WIDTH - FOURIER_WIDTH
N_Q_HEADS = ATTN_WIDTH // HEAD_DIM
GQA_GROUP = 3
N_KV_HEADS = N_Q_HEADS // GQA_GROUP
KV_WIDTH = N_KV_HEADS * HEAD_DIM
FOURIER_GROUP_DIM = 128
N_FOURIER_GROUPS = FOURIER_WIDTH // FOURIER_GROUP_DIM
IN_WIDTH = ATTN_WIDTH + 2 * KV_WIDTH + FOURIER_WIDTH
WINDOW = 128
BLOCK = 128
D_FF = ((8 * D_MODEL // 3 + 127) // 128) * 128
CONV_WIDTH = 3
EPS = 1e-6
NEG_INF = -1e30

kernel_name = "hybrid_window_gqa_fnet_convffn_block"


def _rmsnorm(x, g):
    xf = x.astype(jnp.float32)
    y = xf * lax.rsqrt(jnp.mean(xf * xf, axis=-1, keepdims=True) + EPS)
    return (y * g.astype(jnp.float32)).astype(x.dtype)


def _alibi_slopes(n_heads):
    def pow2_slopes(n):
        start = 2.0 ** (-8.0 / n)
        return [start ** (i + 1) for i in range(n)]
    if math.log2(n_heads).is_integer():
        s = pow2_slopes(n_heads)
    else:
        closest = 2 ** int(math.floor(math.log2(n_heads)))
        s = pow2_slopes(closest) + pow2_slopes(2 * closest)[0::2][: n_heads - closest]
    return jnp.asarray(np.array(s, dtype=np.float32))


def _window_attention(q, k, v, sink):
    B, S = q.shape[0], q.shape[1]
    nb = S // BLOCK
    qb = q.reshape(B, nb, BLOCK, N_KV_HEADS, GQA_GROUP, HEAD_DIM)

    def band(t):
        tb = t.reshape(B, nb, BLOCK, N_KV_HEADS, HEAD_DIM)
        tp = jnp.pad(tb, ((0, 0), (1, 1), (0, 0), (0, 0), (0, 0)))
        return jnp.concatenate([tp[:, :-2], tp[:, 1:-1], tp[:, 2:]], axis=2)

    kb, vb = band(k), band(v)
    scores = jnp.einsum('bnqkgd,bnskd->bnkgqs', qb, kb).astype(jnp.float32)
    scores = scores * (HEAD_DIM ** -0.5)

    qi = jnp.arange(BLOCK)[:, None]
    kj = jnp.arange(3 * BLOCK)[None, :]
    rel = kj - BLOCK - qi
    s_abs = jnp.arange(nb)[:, None, None] * BLOCK - BLOCK + kj[None]
    valid = (jnp.abs(rel) <= WINDOW)[None] & (s_abs >= 0) & (s_abs < S)

    slopes = _alibi_slopes(N_Q_HEADS).reshape(N_KV_HEADS, GQA_GROUP)
    alibi = -slopes[:, :, None, None] * jnp.abs(rel).astype(jnp.float32)[None, None]
    scores = scores + alibi[None, None]
    scores = jnp.where(valid[None, :, None, None], scores, NEG_INF)

    sink_b = sink.astype(jnp.float32).reshape(1, 1, N_KV_HEADS, GQA_GROUP, 1, 1)
    m = jnp.maximum(jnp.max(scores, axis=-1, keepdims=True), sink_b)
    p = jnp.exp(scores - m)
    p = p / (jnp.sum(p, axis=-1, keepdims=True) + jnp.exp(sink_b - m))
    out = jnp.einsum('bnkgqs,bnskd->bnqkgd', p.astype(v.dtype), vb)
    return out.reshape(B, S, N_Q_HEADS * HEAD_DIM)


def _fourier_mix(u, w_fourier):
    B, S = u.shape[0], u.shape[1]
    ug = u.reshape(B, S, N_FOURIER_GROUPS, FOURIER_GROUP_DIM).astype(jnp.float32)
    f = jnp.real(jnp.fft.fft2(ug, axes=(1, 3), norm='ortho'))
    y = jnp.einsum('bsgc,gcd->bsgd', f.astype(u.dtype), w_fourier)
    return y.reshape(B, S, FOURIER_WIDTH)


def _conv_ffn(h, w_up, dw_w, dw_b, w_down):
    up = h @ w_up
    gate, val = up[..., :D_FF], up[..., D_FF:]
    gate = lax.conv_general_dilated(
        gate, dw_w, window_strides=(1,), padding=((CONV_WIDTH // 2, CONV_WIDTH // 2),),
        dimension_numbers=('NWC', 'WIO', 'NWC'), feature_group_count=D_FF) + dw_b
    act = jax.nn.gelu(gate, approximate=False) * val
    return act @ w_down


def setup_inputs(seed: int = 0) -> dict:
    key = jax.random.key(seed)
    ks = jax.random.split(key, 16)
    f32 = jnp.float32
    x = jax.random.normal(ks[0], (BATCH, SEQ, D_MODEL), f32)
    norm1_g = 1.0 + 0.02 * jax.random.normal(ks[1], (D_MODEL,), f32)
    w_in = jax.random.normal(ks[2], (D_MODEL, IN_WIDTH), f32) * D_MODEL ** -0.5
    sink = 0.5 * jax.random.normal(ks[3], (N_Q_HEADS,), f32)
    w_fourier = jax.random.normal(ks[4], (N_FOURIER_GROUPS, FOURIER_GROUP_DIM, FOURIER_GROUP_DIM), f32) * FOURIER_GROUP_DIM ** -0.5
    attn_out_g = 1.0 + 0.02 * jax.random.normal(ks[5], (ATTN_WIDTH,), f32)
    fourier_out_g = 1.0 + 0.02 * jax.random.normal(ks[6], (FOURIER_WIDTH,), f32)
    w_out = jax.random.normal(ks[7], (MIX_WIDTH, D_MODEL), f32) * MIX_WIDTH ** -0.5
    norm2_g = 1.0 + 0.02 * jax.random.normal(ks[8], (D_MODEL,), f32)
    w_up = jax.random.normal(ks[9], (D_MODEL, 2 * D_FF), f32) * D_MODEL ** -0.5
    dw_w = jax.random.normal(ks[10], (CONV_WIDTH, 1, D_FF), f32) * CONV_WIDTH ** -0.5
    dw_b = 0.02 * jax.random.normal(ks[11], (D_FF,), f32)
    w_down = jax.random.normal(ks[12], (D_FF, D_MODEL), f32) * D_FF ** -0.5
    normf_g = 1.0 + 0.02 * jax.random.normal(ks[13], (D_MODEL,), f32)
    return {"x": x, "norm1_g": norm1_g, "w_in": w_in, "sink": sink, "w_fourier": w_fourier,
            "attn_out_g": attn_out_g, "fourier_out_g": fourier_out_g, "w_out": w_out,
            "norm2_g": norm2_g, "w_up": w_up, "dw_w": dw_w, "dw_b": dw_b, "w_down": w_down,
            "normf_g": normf_g}


def reference(x, norm1_g, w_in, sink, w_fourier, attn_out_g, fourier_out_g, w_out,
              norm2_g, w_up, dw_w, dw_b, w_down, normf_g):
    for _ in range(DEPTH):
        h = _rmsnorm(x, norm1_g)
        proj = h @ w_in
        q = proj[..., :ATTN_WIDTH]
        k = proj[..., ATTN_WIDTH:ATTN_WIDTH + KV_WIDTH]
        v = proj[..., ATTN_WIDTH + KV_WIDTH:ATTN_WIDTH + 2 * KV_WIDTH]
        u = proj[..., ATTN_WIDTH + 2 * KV_WIDTH:]
        a = _rmsnorm(_window_attention(q, k, v, sink), attn_out_g)
        f = _rmsnorm(_fourier_mix(u, w_fourier), fourier_out_g)
        x = x + jnp.concatenate([a, f], axis=-1) @ w_out
        x = x + _conv_ffn(_rmsnorm(x, norm2_g), w_up, dw_w, dw_b, w_down)
    return _rmsnorm(x, normf_g)
```

```cpp
#include <hip/hip_runtime.h>
#include <hip/hip_cooperative_groups.h>
#include <cstdio>
#include <cstdint>
namespace cg = cooperative_groups;
namespace pg8 {
#define PG8_LAS __attribute__((address_space(3)))
typedef unsigned short bf16_t;
typedef short bf16x8 __attribute__((ext_vector_type(8)));
typedef float f32x4 __attribute__((ext_vector_type(4)));
typedef unsigned u32x4 __attribute__((ext_vector_type(4)));
constexpr int BM = 256, BK = 64, HALF = 128, HTB = HALF * BK * 2  , STAGE_BYTES = 8 * HTB, NXCD = 8, WGM = 8;

__host__ __device__ __forceinline__ int lds_byte(int r, int c) { const int st = (r >> 4) * 2 + (c >> 5), rr = r & 15, cc = c & 31, ob = rr * 64 + cc * 2; return st * 1024 + (ob ^ (((ob >> 9) & 1) << 5)); }
__host__ __device__ __forceinline__ void stage_rc(int b, int& R, int& C) { const int st = b / 1024, sb = b % 1024, swz = sb ^ (((sb >> 9) & 1) << 5); R = (st >> 1) * 16 + swz / 64; C = (st & 1) * 32 + (swz % 64) / 2; }
__host__ __device__ __forceinline__ int perm32(int rho) { const int n = rho >> 4, i = rho & 15; return 8 * (i >> 2) + 4 * n + (i & 3); }

struct Unit { int pm, pn; };
struct Gemm { const bf16_t* A; const bf16_t* Bt; int M, N, K; int bmode; };

struct StaticOrder {
    int nM, nN, nwg, G, c;
    __host__ __device__ void init(int M, int N, int G_, int c_) { nM = M / BM; nN = N / BM; nwg = nM * nN; G = G_; c = c_; }
    __host__ __device__ bool next(int i, Unit& u) const {
        const long L = (long)i * G + c; if (L >= nwg) return false;
        int wgid = (int)L; { const int q = nwg / NXCD, r = nwg % NXCD, xcd = wgid % NXCD, off = wgid / NXCD; wgid = (xcd < r ? xcd * (q + 1) : r * (q + 1) + (xcd - r) * q) + off; }
        const int nig = WGM * nN, gid = wgid / nig, fm = gid * WGM, gsz = (nM - fm) < WGM ? (nM - fm) : WGM;
        u.pm = fm + ((wgid % nig) % gsz); u.pn = (wgid % nig) / gsz; return true;
    }
    __device__ __forceinline__ void a_ready(const Unit&) const {}
    __device__ __forceinline__ void done(const Unit&) const {}
};

__device__ __forceinline__ unsigned cvt_pk_bf16(float lo, float hi) { unsigned r; asm volatile("v_cvt_pk_bf16_f32 %0, %1, %2" : "=v"(r) : "v"(lo), "v"(hi)); return r; }
typedef float f32x2 __attribute__((ext_vector_type(2)));
typedef unsigned u32x2 __attribute__((ext_vector_type(2)));
__device__ __forceinline__ f32x2 gelu_pk(f32x2 v) {
    const f32x2 av = __builtin_elementwise_abs(v), d = av * 0.2316418882f + 1.0f;
    f32x2 t; t.x = __builtin_amdgcn_rcpf(d.x); t.y = __builtin_amdgcn_rcpf(d.y);
    f32x2 q = t * 0.5307027145f + (-0.7265760135f); q = q * t + 0.7107068705f; q = q * t + (-0.142248368f); q = q * t + 0.127414796f; q = q * t;
    const f32x2 s = (v * v) * (-0.72134752044f);
    f32x2 e; e.x = __builtin_amdgcn_exp2f(s.x); e.y = __builtin_amdgcn_exp2f(s.y);
    const f32x2 m = v * (q * e), r = v - m;
    f32x2 o; o.x = v.x < 0.f ? m.x : r.x; o.y = v.y < 0.f ? m.y : r.y; return o;
}
#define EPI_BAR() do { asm volatile("s_waitcnt lgkmcnt(0)" ::: "memory"); __builtin_amdgcn_s_barrier(); asm volatile("" ::: "memory"); } while (0)
constexpr float RMS_EPS = 1e-6f;

struct EpiQK {
    static constexpr bool PERM = true, AFTER_DRAIN = false;
    bf16_t* Q; bf16_t* Kb; const float* rs1; float qscale;
    __device__ __forceinline__ void operator()(f32x4 (&acc)[2][2][4][2], const Unit& u, int wr, int wc, int fr, int fq) const {
        const int row0 = u.pm * BM + wr * 64 + fr; const int colt = u.pn * BM;
        bf16_t* base; int ldc; float sc;
        if (colt < 1536) { base = Q + colt; ldc = 1536; sc = qscale; } else { base = Kb + (colt - 1536); ldc = 512; sc = 1.f; }
        const int col0 = wc * 32 + 8 * fq;
#pragma unroll
        for (int ai = 0; ai < 2; ++ai)
#pragma unroll
            for (int m = 0; m < 4; ++m) { const int row = row0 + ai * HALF + m * 16; const float s = rs1[row] * sc; bf16_t* rowp = base + (size_t)row * ldc + col0;
#pragma unroll
                for (int bj = 0; bj < 2; ++bj) { const f32x4 v0 = acc[ai][bj][m][0] * s, v1 = acc[ai][bj][m][1] * s;
                    u32x4 w; w.x = cvt_pk_bf16(v0[0], v0[1]); w.y = cvt_pk_bf16(v0[2], v0[3]); w.z = cvt_pk_bf16(v1[0], v1[1]); w.w = cvt_pk_bf16(v1[2], v1[3]);
                    *(u32x4*)(rowp + bj * HALF) = w; } }
    }
};
struct EpiVT {
    static constexpr bool PERM = false, AFTER_DRAIN = false;
    bf16_t* O; const float* rs1;
    __device__ __forceinline__ void operator()(f32x4 (&acc)[2][2][4][2], const Unit& u, int wr, int wc, int fr, int fq) const {
        const int row0 = u.pm * BM + wr * 64 + fr;
#pragma unroll
        for (int bj = 0; bj < 2; ++bj) {
            const int tok0 = u.pn * BM + bj * HALF + wc * 32 + 4 * fq;
            const f32x4 s0 = *(const f32x4*)(rs1 + tok0), s1 = *(const f32x4*)(rs1 + tok0 + 16);
            const int pos0 = u.pn * BM + bj * HALF + wc * 32 + 8 * fq;
#pragma unroll
            for (int ai = 0; ai < 2; ++ai)
#pragma unroll
                for (int m = 0; m < 4; ++m) { const int row = row0 + ai * HALF + m * 16; const f32x4 v0 = acc[ai][bj][m][0] * s0, v1 = acc[ai][bj][m][1] * s1;
                    u32x4 w; w.x = cvt_pk_bf16(v0[0], v0[1]); w.y = cvt_pk_bf16(v0[2], v0[3]); w.z = cvt_pk_bf16(v1[0], v1[1]); w.w = cvt_pk_bf16(v1[2], v1[3]);
                    *(u32x4*)(O + (size_t)row * 8192 + pos0) = w; }
        }
    }
};
struct EpiUP {
    static constexpr bool PERM = true, AFTER_DRAIN = false;
    bf16_t* O; const float* rs1;
    __device__ __forceinline__ void operator()(f32x4 (&acc)[2][2][4][2], const Unit& u, int wr, int wc, int fr, int fq) const {
        const int row0 = u.pm * BM + wr * 64 + fr;
#pragma unroll
        for (int bj = 0; bj < 2; ++bj) {
            const int s2 = 4 * u.pn + 2 * bj + (wc >> 1); const int s1b = 32 * (wc & 1) + 8 * fq;
            float sc[8];
#pragma unroll
            for (int e = 0; e < 8; ++e) sc[e] = rs1[128 * (s1b + e) + s2];
            const int pos0 = u.pn * BM + bj * HALF + wc * 32 + 8 * fq;
#pragma unroll
            for (int ai = 0; ai < 2; ++ai)
#pragma unroll
                for (int m = 0; m < 4; ++m) { const int row = row0 + ai * HALF + m * 16; const f32x4 v0 = acc[ai][bj][m][0], v1 = acc[ai][bj][m][1];
                    u32x4 w; w.x = cvt_pk_bf16(v0[0] * sc[0], v0[1] * sc[1]); w.y = cvt_pk_bf16(v0[2] * sc[2], v0[3] * sc[3]); w.z = cvt_pk_bf16(v1[0] * sc[4], v1[1] * sc[5]); w.w = cvt_pk_bf16(v1[2] * sc[6], v1[3] * sc[7]);
                    *(u32x4*)(O + (size_t)row * 8192 + pos0) = w; }
        }
    }
};
struct EpiRes {
    static constexpr bool PERM = false, AFTER_DRAIN = false;
    const float* base; float* out; bf16_t* outb; const float* rowscale; float* ssq; PG8_LAS unsigned char* scr;
    __device__ __forceinline__ void operator()(f32x4 (&acc)[2][2][4][2], const Unit& u, int wr, int wc, int fr, int fq) const {
        const int col0 = u.pn * BM + wc * 32 + 4 * fq;
        PG8_LAS float* P = (PG8_LAS float*)scr;
#pragma unroll
        for (int ai = 0; ai < 2; ++ai)
#pragma unroll
            for (int m = 0; m < 4; ++m) { const int r = ai * HALF + wr * 64 + m * 16 + fr; const int row = u.pm * BM + r; const float sc = rowscale ? rowscale[row] : 1.f; float s = 0.f;
#pragma unroll
                for (int bj = 0; bj < 2; ++bj)
#pragma unroll
                    for (int n = 0; n < 2; ++n) { const size_t off = (size_t)row * 2048 + col0 + bj * HALF + n * 16; const f32x4 b = *(const f32x4*)(base + off); const f32x4 o = b + acc[ai][bj][m][n] * sc;
                        *(f32x4*)(out + off) = o; s += (o[0] * o[0] + o[1] * o[1]) + (o[2] * o[2] + o[3] * o[3]);
                        if (outb) { u32x2 w; w.x = cvt_pk_bf16(o[0], o[1]); w.y = cvt_pk_bf16(o[2], o[3]); *(u32x2*)(outb + off) = w; } }
                s += __shfl_xor(s, 16); s += __shfl_xor(s, 32);
                if (fq == 0) P[r * 4 + wc] = s; }
        EPI_BAR();
        const int tid = threadIdx.x;
        if (tid < 256) { const f32x4 p = *(const PG8_LAS f32x4*)(P + tid * 4); ssq[(size_t)(u.pm * BM + tid) * 8 + u.pn] = (p[0] + p[1]) + (p[2] + p[3]); }
    }
};
struct EpiUp {
    static constexpr bool PERM = false, AFTER_DRAIN = false;
    bf16_t* act; const float* ssq1; const float* dww; const float* dwb; float* edge; PG8_LAS unsigned char* scr;
    __device__ __forceinline__ void operator()(f32x4 (&acc)[2][2][4][2], const Unit& u, int wr, int wc, int fr, int fq) const {
        const int lane = threadIdx.x & 63;
#pragma unroll
        for (int ai = 0; ai < 2; ++ai)
#pragma unroll
            for (int m = 0; m < 4; ++m) { const int row = u.pm * BM + ai * HALF + wr * 64 + m * 16 + fr; const f32x4 a = *(const f32x4*)(ssq1 + (size_t)row * 8), b = *(const f32x4*)(ssq1 + (size_t)row * 8 + 4);
                const float t = ((a[0] + a[1]) + (a[2] + a[3])) + ((b[0] + b[1]) + (b[2] + b[3])); const float rs = 1.0f / sqrtf(t * (1.0f / 2048.0f) + RMS_EPS);
#pragma unroll
                for (int bj = 0; bj < 2; ++bj)
#pragma unroll
                    for (int n = 0; n < 2; ++n) acc[ai][bj][m][n] *= rs; }
        PG8_LAS float* halo = (PG8_LAS float*)scr;
        const int cl = 32 * wc + 4 * fq;
#pragma unroll
        for (int ai = 0; ai < 2; ++ai) { const int seg = 2 * ai + wr;
            if (fr == 0) {
#pragma unroll
                for (int n = 0; n < 2; ++n) *(PG8_LAS f32x4*)(halo + (seg * 2 + 0) * 128 + cl + 16 * n) = acc[ai][0][0][n]; }
            if (fr == 15) {
#pragma unroll
                for (int n = 0; n < 2; ++n) *(PG8_LAS f32x4*)(halo + (seg * 2 + 1) * 128 + cl + 16 * n) = acc[ai][0][3][n]; } }
        EPI_BAR();
        const int c0 = 128 * u.pn + cl;
        const int src_up = (lane & 48) | ((fr + 15) & 15), src_dn = (lane & 48) | ((fr + 1) & 15);
#pragma unroll
        for (int n = 0; n < 2; ++n) {
            const f32x4 w0 = *(const f32x4*)(dww + c0 + 16 * n), w1 = *(const f32x4*)(dww + 5504 + c0 + 16 * n), w2 = *(const f32x4*)(dww + 11008 + c0 + 16 * n), bb = *(const f32x4*)(dwb + c0 + 16 * n);
#pragma unroll
            for (int ai = 0; ai < 2; ++ai) { const int seg = 2 * ai + wr;
                f32x4 hu = (f32x4){0.f, 0.f, 0.f, 0.f}, hd = (f32x4){0.f, 0.f, 0.f, 0.f};
                if (seg > 0) hu = *(const PG8_LAS f32x4*)(halo + ((seg - 1) * 2 + 1) * 128 + cl + 16 * n);
                if (seg < 3) hd = *(const PG8_LAS f32x4*)(halo + ((seg + 1) * 2 + 0) * 128 + cl + 16 * n);
#pragma unroll
                for (int m = 0; m < 4; ++m) {
                    const f32x4 G = acc[ai][0][m][n];
                    f32x4 xu = G, xd = G;
                    if (m > 0 && fr == 15) xu = acc[ai][0][m - 1][n];
                    if (m < 3 && fr == 0) xd = acc[ai][0][m + 1][n];
                    f32x4 U, D;
#pragma unroll
                    for (int e = 0; e < 4; ++e) { U[e] = __shfl(xu[e], src_up); D[e] = __shfl(xd[e], src_dn); }
                    if (m == 0 && fr == 0) U = hu;
                    if (m == 3 && fr == 15) D = hd;
                    const f32x4 gp = w0 * U + w1 * G + w2 * D + bb;
                    const f32x4 V = acc[ai][1][m][n];
                    const f32x2 g0 = gelu_pk((f32x2){gp[0], gp[1]}), g1 = gelu_pk((f32x2){gp[2], gp[3]});
                    const int row = u.pm * BM + ai * HALF + wr * 64 + m * 16 + fr;
                    u32x2 w; w.x = cvt_pk_bf16(g0.x * V[0], g0.y * V[1]); w.y = cvt_pk_bf16(g1.x * V[2], g1.y * V[3]);
                    *(u32x2*)(act + (size_t)row * 5504 + c0 + 16 * n) = w;
                    if (ai == 0 && m == 0 && wr == 0 && fr == 0) { float* e0 = edge + (size_t)((u.pm * 2 + 0) * 3) * 5504 + c0 + 16 * n;
                        *(f32x4*)(e0) = gp; *(f32x4*)(e0 + 5504) = V; *(f32x4*)(e0 + 2 * 5504) = G; }
                    if (ai == 1 && m == 3 && wr == 1 && fr == 15) { float* e1 = edge + (size_t)((u.pm * 2 + 1) * 3) * 5504 + c0 + 16 * n;
                        *(f32x4*)(e1) = gp; *(f32x4*)(e1 + 5504) = V; *(f32x4*)(e1 + 2 * 5504) = G; }
                }
            }
        }
    }
};
template <class Epi, class Sched, bool ALIGN_EPI = false, bool SP2 = false>
__device__ __forceinline__ void gemm_phase(PG8_LAS unsigned char* lds, const Gemm g, const Sched& S, const Epi& E) {
    const int tid = threadIdx.x, wid = __builtin_amdgcn_readfirstlane(tid >> 6), lane = tid & 63, wr = wid >> 2, wc = wid & 3, fr = lane & 15, fq = lane >> 4;
    const int K = g.K, nt = K / BK;
    unsigned voffA[2], voffB[2];
#pragma unroll
    for (int i = 0; i < 2; ++i) { int R, C; stage_rc(tid * 16 + i * 8192, R, C); const int Rb = Epi::PERM ? ((R & ~31) + perm32(R & 31)) : R;
        voffA[i] = (unsigned)(R * K + C) * 2u; voffB[i] = g.bmode ? (unsigned)(((Rb & 63) * 128 + (Rb >> 6)) * K + C) * 2u : (unsigned)(Rb * K + C) * 2u; }
    const size_t kstep = (size_t)(BK * 2);
    const size_t hstepA = (size_t)HALF * K * 2; const size_t hstepB = g.bmode ? (size_t)2 * K * 2 : hstepA;
    const size_t tstepA = 2 * hstepA; const size_t tstepB = 2 * hstepB;
    const unsigned ldsw = (unsigned)wid * 1024u;
    const int aoff = lds_byte(wr * 64 + fr, fq * 8), boff = lds_byte(wc * 32 + fr, fq * 8);
#define PG8_SA(b, h) (((b) * 2 + (h)) * HTB)
#define PG8_SB(b, h) ((4 + (b) * 2 + (h)) * HTB)
#define PG8_STAGE(bufoff, gbase, voff) do { _Pragma("unroll") for (int _i = 0; _i < 2; ++_i) \
        __builtin_amdgcn_global_load_lds((const unsigned*)((const char*)(gbase) + (voff)[_i]), (PG8_LAS unsigned*)(lds + (bufoff) + ldsw + _i * 8192), 16, 0, 0); } while (0)
#define PG8_LDA(dst, b, h) do { _Pragma("unroll") for (int m = 0; m < 4; ++m) _Pragma("unroll") for (int k = 0; k < 2; ++k) dst[m][k] = *(const PG8_LAS bf16x8*)(lds + PG8_SA(b, h) + aoff + m * 2048 + k * 1024); } while (0)
#define PG8_LDB(dst, b, h) do { _Pragma("unroll") for (int n = 0; n < 2; ++n) _Pragma("unroll") for (int k = 0; k < 2; ++k) dst[n][k] = *(const PG8_LAS bf16x8*)(lds + PG8_SB(b, h) + boff + n * 2048 + k * 1024); } while (0)
#define PG8_MMA(ai, bj, At, Bt) do { __builtin_amdgcn_s_setprio(1); _Pragma("unroll") for (int m = 0; m < 4; ++m) _Pragma("unroll") for (int n = 0; n < 2; ++n) _Pragma("unroll") for (int k = 0; k < 2; ++k) \
        acc[ai][bj][m][n] = __builtin_amdgcn_mfma_f32_16x16x32_bf16(Bt[n][k], At[m][k], acc[ai][bj][m][n], 0, 0, 0); __builtin_amdgcn_s_setprio(0); } while (0)
#define PG8_WAIT_V(n) asm volatile("s_waitcnt vmcnt(" #n ")" ::: "memory")
#define PG8_WAIT_L(n) asm volatile("s_waitcnt lgkmcnt(" #n ")" ::: "memory")
#define PG8_BAR __builtin_amdgcn_s_barrier()
#define PG8_SCHED __builtin_amdgcn_sched_barrier(0)
    Unit cur, nxt; int ui = 0;
    if (!S.next(0, cur)) return;
    f32x4 acc[2][2][4][2];
#pragma unroll
    for (int a = 0; a < 2; ++a)
#pragma unroll
        for (int b = 0; b < 2; ++b)
#pragma unroll
            for (int m = 0; m < 4; ++m)
#pragma unroll
                for (int n = 0; n < 2; ++n) acc[a][b][m][n] = (f32x4){0.f, 0.f, 0.f, 0.f};
    bf16x8 At[4][2], B0[2][2], B1[2][2];
    const char* cA = (const char*)g.A + (size_t)cur.pm * tstepA; const char* cB = (const char*)g.Bt + (size_t)cur.pn * tstepB;
    S.a_ready(cur);
    if constexpr (SP2) {
        PG8_STAGE(PG8_SB(0, 0), cB, voffB); PG8_STAGE(PG8_SB(0, 1), cB + hstepB, voffB); PG8_STAGE(PG8_SA(0, 0), cA, voffA); PG8_STAGE(PG8_SA(0, 1), cA + hstepA, voffA);
        if (wr == 1) PG8_BAR;
        PG8_WAIT_V(2); PG8_BAR;
        PG8_STAGE(PG8_SB(1, 0), cB + kstep, voffB); PG8_STAGE(PG8_SA(1, 0), cA + kstep, voffA); PG8_STAGE(PG8_SB(1, 1), cB + hstepB + kstep, voffB);
        PG8_WAIT_V(6); PG8_BAR;
    } else {
        PG8_STAGE(PG8_SB(0, 0), cB, voffB); PG8_STAGE(PG8_SA(0, 0), cA, voffA); PG8_STAGE(PG8_SB(0, 1), cB + hstepB, voffB); PG8_STAGE(PG8_SA(0, 1), cA + hstepA, voffA);
        if (wr == 1) PG8_BAR;
        PG8_WAIT_V(4); PG8_BAR;
        PG8_STAGE(PG8_SB(1, 0), cB + kstep, voffB); PG8_STAGE(PG8_SA(1, 0), cA + kstep, voffA); PG8_STAGE(PG8_SB(1, 1), cB + hstepB + kstep, voffB);
        PG8_WAIT_V(6); PG8_BAR;
    }
    for (;;) {
        const bool has_next = S.next(ui + 1, nxt);
        const char* nA = has_next ? (const char*)g.A + (size_t)nxt.pm * tstepA : cA; const char* nB = has_next ? (const char*)g.Bt + (size_t)nxt.pn * tstepB : cB;
        for (int t = 0; t < nt; t += 2) {
            const bool last = (t == nt - 2);
            const char* a1 = cA + (size_t)(t + 1) * kstep;
            const char* a2 = last ? nA : cA + (size_t)(t + 2) * kstep; const char* b2 = last ? nB : cB + (size_t)(t + 2) * kstep;
            const char* a3 = a2 + kstep; const char* b3 = b2 + kstep;
            if (last && has_next) S.a_ready(nxt);
            if constexpr (SP2) {
            PG8_LDB(B0, 0, 0); PG8_LDB(B1, 0, 1); PG8_SCHED; PG8_LDA(At, 0, 0); PG8_STAGE(PG8_SA(1, 1), a1 + hstepA, voffA);
            PG8_WAIT_V(8); PG8_WAIT_L(0); PG8_BAR; PG8_MMA(0, 0, At, B0); PG8_MMA(0, 1, At, B1); PG8_BAR; PG8_SCHED;
            PG8_LDA(At, 0, 1); PG8_STAGE(PG8_SB(0, 0), b2, voffB); PG8_STAGE(PG8_SB(0, 1), b2 + hstepB, voffB); PG8_STAGE(PG8_SA(0, 0), a2, voffA);
            PG8_WAIT_V(8); PG8_WAIT_L(0); PG8_BAR; PG8_MMA(1, 0, At, B0); PG8_MMA(1, 1, At, B1); PG8_BAR; PG8_SCHED;
            PG8_LDB(B0, 1, 0); PG8_LDB(B1, 1, 1); PG8_SCHED; PG8_LDA(At, 1, 0); PG8_STAGE(PG8_SA(0, 1), a2 + hstepA, voffA);
            PG8_WAIT_V(8); PG8_WAIT_L(0); PG8_BAR; PG8_MMA(0, 0, At, B0); PG8_MMA(0, 1, At, B1); PG8_BAR; PG8_SCHED;
            PG8_LDA(At, 1, 1); PG8_STAGE(PG8_SB(1, 0), b3, voffB); PG8_STAGE(PG8_SB(1, 1), b3 + hstepB, voffB); PG8_STAGE(PG8_SA(1, 0), a3, voffA);
            PG8_WAIT_V(8); PG8_WAIT_L(0); PG8_BAR; PG8_MMA(1, 0, At, B0); PG8_MMA(1, 1, At, B1); PG8_BAR; PG8_SCHED;
            } else {
            PG8_LDB(B0, 0, 0); PG8_SCHED; PG8_LDA(At, 0, 0); PG8_STAGE(PG8_SA(1, 1), a1 + hstepA, voffA);
            PG8_WAIT_L(8); PG8_BAR; PG8_WAIT_L(0); PG8_MMA(0, 0, At, B0); PG8_BAR; PG8_SCHED;
            PG8_LDB(B1, 0, 1); PG8_STAGE(PG8_SB(0, 0), b2, voffB);
            PG8_BAR; PG8_WAIT_L(0); PG8_MMA(0, 1, At, B1); PG8_BAR;
            PG8_LDA(At, 0, 1); PG8_STAGE(PG8_SA(0, 0), a2, voffA);
            PG8_BAR; PG8_WAIT_L(0); PG8_MMA(1, 0, At, B0); PG8_BAR; PG8_SCHED;
            PG8_STAGE(PG8_SB(0, 1), b2 + hstepB, voffB);
            PG8_WAIT_V(6); PG8_BAR; PG8_MMA(1, 1, At, B1); PG8_BAR;
            PG8_LDB(B0, 1, 0); PG8_SCHED; PG8_LDA(At, 1, 0); PG8_STAGE(PG8_SA(0, 1), a2 + hstepA, voffA);
            PG8_WAIT_L(8); PG8_BAR; PG8_WAIT_L(0); PG8_MMA(0, 0, At, B0); PG8_BAR; PG8_SCHED;
            PG8_LDB(B1, 1, 1); PG8_STAGE(PG8_SB(1, 0), b3, voffB);
            PG8_BAR; PG8_WAIT_L(0); PG8_MMA(0, 1, At, B1); PG8_BAR;
            PG8_LDA(At, 1, 1); PG8_STAGE(PG8_SA(1, 0), a3, voffA);
            PG8_BAR; PG8_WAIT_L(0); PG8_MMA(1, 0, At, B0); PG8_BAR; PG8_SCHED;
            PG8_STAGE(PG8_SB(1, 1), b3 + hstepB, voffB);
            PG8_WAIT_V(6); PG8_BAR; PG8_MMA(1, 1, At, B1); PG8_BAR;
            }
        }
        if constexpr (ALIGN_EPI) { if (wr == 0) PG8_BAR; }
        if constexpr (!Epi::AFTER_DRAIN) { E(acc, cur, wr, wc, fr, fq); S.done(cur); }
        if (!has_next) break;
#pragma unroll
        for (int a = 0; a < 2; ++a)
#pragma unroll
            for (int b = 0; b < 2; ++b)
#pragma unroll
                for (int m = 0; m < 4; ++m)
#pragma unroll
                    for (int n = 0; n < 2; ++n) acc[a][b][m][n] = (f32x4){0.f, 0.f, 0.f, 0.f};
        cur = nxt; cA = nA; cB = nB; ++ui;
        if constexpr (ALIGN_EPI) { if (wr == 1) PG8_BAR; }
    }
    PG8_WAIT_V(0);
    if constexpr (!ALIGN_EPI) { if (wr == 0) PG8_BAR; }
    PG8_BAR;
    if constexpr (Epi::AFTER_DRAIN) { E.fused(acc, cur, wr, wc, fr, fq, lds, wid, lane); S.done(cur); }
#undef PG8_SA
#undef PG8_SB
#undef PG8_STAGE
#undef PG8_LDA
#undef PG8_LDB
#undef PG8_MMA
#undef PG8_WAIT_V
#undef PG8_WAIT_L
#undef PG8_BAR
#undef PG8_SCHED
}
}
constexpr int SEQ = 8192, DM = 2048, NQ = 1536, NKV = 512, NFO = 512, NIN = 3072, DFF = 5504, NUP = 11008;
using pg8::RMS_EPS;
constexpr size_t MiB = 1u << 20;
constexpr size_t WS_WIN = 0, WS_WOUT = 12 * MiB, WS_WUP = 20 * MiB, WS_WDOWN = 63 * MiB;
constexpr size_t WS_XB = 85 * MiB, WS_Q = 117 * MiB, WS_K = 141 * MiB, WS_VT = 149 * MiB, WS_UP = 157 * MiB, WS_MIX = 165 * MiB, WS_YB = 197 * MiB, WS_VB = 213 * MiB;
constexpr size_t WS_ACT = 85 * MiB;
constexpr size_t WS_SMALL = 229 * MiB;
constexpr size_t WS_RS1 = WS_SMALL, WS_RSA = WS_SMALL + 32768, WS_SSQA = WS_SMALL + 65536, WS_SSQ1 = WS_SMALL + 524288, WS_SSQ2 = WS_SMALL + 786432;
constexpr size_t WS_W64 = WS_SMALL + 1048576, WS_BT3 = WS_SMALL + 1114112, WS_WCS = WS_SMALL + 1310720, WS_EDGE = WS_SMALL + 2 * MiB;
constexpr size_t WS_X1B = 240 * MiB, WS_END = 272 * MiB;
static_assert(WS_ACT + (size_t)SEQ * DFF * 2 <= WS_YB + 16 * MiB && WS_EDGE + (size_t)64 * 3 * DFF * 4 <= WS_X1B, "ws map");
constexpr int RING_BYTES = 131072, SCR_OFF = RING_BYTES + 512, LDS_BYTES = 147456;
constexpr int NWAVES = 8, NTHREADS = 512;
#define LAS __attribute__((address_space(3)))
typedef unsigned short bf16;
typedef float f32x4 __attribute__((ext_vector_type(4)));
typedef short bf16x8 __attribute__((ext_vector_type(8)));
typedef unsigned u32x4 __attribute__((ext_vector_type(4)));
typedef unsigned u32x2 __attribute__((ext_vector_type(2)));
__device__ __forceinline__ unsigned f2bf(float f) { unsigned u = __builtin_bit_cast(unsigned, f); return (u + 0x7fffu + ((u >> 16) & 1u)) >> 16; }
__device__ __forceinline__ unsigned pk2(float lo, float hi) { return f2bf(lo) | (f2bf(hi) << 16); }
__device__ __forceinline__ float wave_sum(float v) {
#pragma unroll
    for (int o = 1; o < 64; o <<= 1) v += __shfl_xor(v, o);
    return v;
}
#define MFMA16(a, b, c) __builtin_amdgcn_mfma_f32_16x16x32_bf16((a), (b), (c), 0, 0, 0)

struct Args { const float* in[14]; float* out; unsigned char* ws; int ph_lo, ph_hi; };

__device__ __forceinline__ void p0_item(const float* W, int K, int N, bf16* WT, int out_row0, const float* ksc, float* scr, int k0, int n0, int lane) {
#pragma unroll 8
    for (int i = 0; i < 32; ++i) { const int kk = 2 * i + (lane >> 5); const float s = ksc ? ksc[k0 + kk] : 1.f; scr[kk * 33 + (lane & 31)] = W[(size_t)(k0 + kk) * N + n0 + (lane & 31)] * s; }
    asm volatile("s_waitcnt lgkmcnt(0)" ::: "memory");
    const int c = lane & 7;
#pragma unroll
    for (int j = 0; j < 4; ++j) { const int n = (lane >> 3) + 8 * j; const float* s = scr + (8 * c) * 33 + n;
        u32x4 o; o.x = pk2(s[0 * 33], s[1 * 33]); o.y = pk2(s[2 * 33], s[3 * 33]); o.z = pk2(s[4 * 33], s[5 * 33]); o.w = pk2(s[6 * 33], s[7 * 33]);
        *(u32x4*)(WT + (size_t)(out_row0 + n) * K + k0 + 8 * c) = o; }
    asm volatile("s_waitcnt lgkmcnt(0)" ::: "memory");
}
__device__ __forceinline__ void p0_prologue(const Args& A, unsigned char* lds) {
    const int tid = threadIdx.x, lane = tid & 63, wave = tid >> 6;
    const int gw = blockIdx.x * NWAVES + wave, NGW = gridDim.x * NWAVES;
    float* scr = (float*)(lds + wave * 16384);
    const float* x = A.in[0]; const float* n1g = A.in[1]; const float* w_in = A.in[2]; const float* w_four = A.in[4]; const float* ag = A.in[5]; const float* fg = A.in[6];
    const float* w_out = A.in[7]; const float* n2g = A.in[8]; const float* w_up = A.in[9]; const float* w_down = A.in[12];
    bf16* WIN = (bf16*)(A.ws + WS_WIN); bf16* WOUT = (bf16*)(A.ws + WS_WOUT); bf16* WUP = (bf16*)(A.ws + WS_WUP); bf16* WDOWN = (bf16*)(A.ws + WS_WDOWN);
    constexpr int I_IN = 32 * 96, I_OUT = 32 * 64, I_UP = 32 * 344, I_DOWN = 86 * 64, NITEMS = I_IN + I_OUT + I_UP + I_DOWN;
    for (int it = gw; it < NITEMS; it += NGW) {
        int r = it;
        if (r < I_IN) { const int kb = r / 96, nb = r % 96; p0_item(w_in, DM, NIN, WIN, 32 * nb, n1g, scr, 64 * kb, 32 * nb, lane); continue; } r -= I_IN;
        if (r < I_OUT) { const int kb = r / 64, nb = r % 64; const int k0 = 64 * kb; p0_item(w_out, DM, DM, WOUT, 32 * nb, k0 < NQ ? ag : fg - NQ, scr, k0, 32 * nb, lane); continue; } r -= I_OUT;
        if (r < I_UP) { const int kb = r / 344, nb = r % 344; const int n0 = 32 * nb; int orow; if (n0 < DFF) orow = 256 * (n0 >> 7) + (n0 & 127); else { const int c = n0 - DFF; orow = 256 * (c >> 7) + 128 + (c & 127); }
            p0_item(w_up, DM, NUP, WUP, orow, n2g, scr, 64 * kb, n0, lane); continue; } r -= I_UP;
        { const int kb = r / 64, nb = r % 64; p0_item(w_down, DFF, DM, WDOWN, 32 * nb, nullptr, scr, 64 * kb, 32 * nb, lane); }
    }
    bf16* XB = (bf16*)(A.ws + WS_XB); float* RS1 = (float*)(A.ws + WS_RS1);
    for (int m = gw; m < SEQ; m += NGW) {
        const f32x4* xr = (const f32x4*)(x + (size_t)m * DM) + lane; f32x4 v[8]; float s = 0.f;
#pragma unroll
        for (int j = 0; j < 8; ++j) { v[j] = xr[64 * j]; s += (v[j][0] * v[j][0] + v[j][1] * v[j][1]) + (v[j][2] * v[j][2] + v[j][3] * v[j][3]); }
        s = wave_sum(s);
        u32x2* o8 = (u32x2*)(XB + (size_t)m * DM) + lane;
#pragma unroll
        for (int j = 0; j < 8; ++j) { u32x2 w; w.x = pk2(v[j][0], v[j][1]); w.y = pk2(v[j][2], v[j][3]); o8[64 * j] = w; }
        if (lane == 0) RS1[m] = 1.0f / sqrtf(s * (1.0f / DM) + RMS_EPS);
    }
    const int gt = blockIdx.x * NTHREADS + tid, NGT = gridDim.x * NTHREADS;
    bf16* W64 = (bf16*)(A.ws + WS_W64); bf16* BT3 = (bf16*)(A.ws + WS_BT3); bf16* WCS = (bf16*)(A.ws + WS_WCS);
    for (int i = gt; i < 128 * 64; i += NGT) { const int n = i >> 6, k = i & 63; float sn, cs; sincospif((float)((k * n) & 63) * (1.0f / 32.0f), &sn, &cs); W64[i] = (bf16)f2bf(n < 64 ? cs : -sn); }
    for (int i = gt; i < 256 * 256; i += NGT) { const int n = i >> 8, k = i & 255; const int k2 = n & 127, s2 = k & 127; float sn, cs; sincospif((float)((s2 * k2) & 127) * (1.0f / 64.0f), &sn, &cs);
        float v; if (n < 128) v = (k < 128) ? cs : sn; else v = (k < 128) ? -sn : cs; BT3[i] = (bf16)f2bf(v); }
    for (int i = gt; i < 4 * 128 * 256; i += NGT) { const int g = i >> 15, d = (i >> 8) & 127, k = i & 255, kk = k & 127; float a = 0.f;
        for (int c = 0; c < 128; ++c) { float sn, cs; sincospif((float)((kk * c) & 127) * (1.0f / 64.0f), &sn, &cs); a += ((k < 128) ? cs : sn) * w_four[(size_t)(g * 128 + c) * 128 + d]; }
        WCS[i] = (bf16)f2bf(a * (1.0f / 1024.0f)); }
}

__device__ __forceinline__ float alibi_slope(int h) { return h < 8 ? exp2f(-(float)(h + 1)) : exp2f(-(0.5f + (float)(h - 8))); }
__device__ __forceinline__ void attn_phase(const Args& A, unsigned char* lds) {
    const int tid = threadIdx.x, lane = tid & 63, wid = tid >> 6, fr = lane & 15, g = lane >> 4;
    constexpr int RS = 272; constexpr float LOG2E = 1.4426950408889634f;
    unsigned char* Ks = lds; unsigned char* Vs = lds + 128 * RS;
    const bf16* Q = (const bf16*)(A.ws + WS_Q); const bf16* Kb = (const bf16*)(A.ws + WS_K); const bf16* VT = (const bf16*)(A.ws + WS_VT);
    bf16* MIX = (bf16*)(A.ws + WS_MIX); float* SSQA = (float*)(A.ws + WS_SSQA); const float* sink = A.in[3];
    for (int unit = blockIdx.x; unit < 768; unit += gridDim.x) {
        const int hq = unit % 12, nb = unit / 12, kvh = hq / 3;
        const int c_lo = nb > 0 ? nb - 1 : 0, c_hi = nb < 63 ? nb + 1 : 63;
        const int tq = 128 * nb + 16 * wid + fr;
        f32x4 o[8]; float mrun = sink[hq] * LOG2E, lrun = 1.f; const float slope2 = alibi_slope(hq) * LOG2E;
#pragma unroll
        for (int dt = 0; dt < 8; ++dt) o[dt] = (f32x4){0.f, 0.f, 0.f, 0.f};
        bf16x8 qf[4];
#pragma unroll
        for (int kk = 0; kk < 4; ++kk) qf[kk] = *(const bf16x8*)(Q + (size_t)tq * NQ + hq * 128 + 32 * kk + 8 * g);
        u32x4 pre[8];
        auto gload = [&](int c) {
#pragma unroll
            for (int i = 0; i < 4; ++i) { const int p = tid + 512 * i, row = p >> 4, c16 = p & 15;
                pre[i] = *(const u32x4*)(Kb + (size_t)(128 * c + row) * NKV + kvh * 128 + c16 * 8);
                pre[4 + i] = *(const u32x4*)(VT + (size_t)(kvh * 128 + row) * SEQ + 128 * c + c16 * 8); } };
        auto lstore = [&]() {
#pragma unroll
            for (int i = 0; i < 4; ++i) { const int p = tid + 512 * i, row = p >> 4, c16 = p & 15;
                *(u32x4*)(Ks + row * RS + c16 * 16) = pre[i]; *(u32x4*)(Vs + row * RS + c16 * 16) = pre[4 + i]; } };
        gload(c_lo); __syncthreads(); lstore(); __syncthreads();
        for (int c = c_lo; c <= c_hi; ++c) {
            if (c < c_hi) gload(c + 1);
            f32x4 s[8];
#pragma unroll
            for (int kt = 0; kt < 8; ++kt) { s[kt] = (f32x4){0.f, 0.f, 0.f, 0.f};
#pragma unroll
                for (int kk = 0; kk < 4; ++kk) { const bf16x8 a = *(const bf16x8*)(Ks + (16 * kt + fr) * RS + (32 * kk + 8 * g) * 2); s[kt] = MFMA16(a, qf[kk], s[kt]); } }
            float mx = -3.0e38f;
#pragma unroll
            for (int kt = 0; kt < 8; ++kt)
#pragma unroll
                for (int r = 0; r < 4; ++r) { const int rel = 128 * c + 16 * kt + 4 * g + r - tq; const int ar = rel < 0 ? -rel : rel;
                    float v = s[kt][r] - slope2 * (float)ar; if (ar > 128) v = -1.0e30f; s[kt][r] = v; mx = fmaxf(mx, v); }
            mx = fmaxf(mx, __shfl_xor(mx, 16)); mx = fmaxf(mx, __shfl_xor(mx, 32));
            const float mnew = fmaxf(mrun, mx); const float alpha = __builtin_amdgcn_exp2f(mrun - mnew); mrun = mnew;
            float sum = 0.f;
#pragma unroll
            for (int kt = 0; kt < 8; ++kt)
#pragma unroll
                for (int r = 0; r < 4; ++r) { const float p = __builtin_amdgcn_exp2f(s[kt][r] - mnew); s[kt][r] = p; sum += p; }
            sum += __shfl_xor(sum, 16); sum += __shfl_xor(sum, 32);
            lrun = lrun * alpha + sum;
#pragma unroll
            for (int dt = 0; dt < 8; ++dt) o[dt] *= alpha;
            bf16x8 pb[4];
#pragma unroll
            for (int ks = 0; ks < 4; ++ks) { u32x4 w; w.x = pk2(s[2 * ks][0], s[2 * ks][1]); w.y = pk2(s[2 * ks][2], s[2 * ks][3]); w.z = pk2(s[2 * ks + 1][0], s[2 * ks + 1][1]); w.w = pk2(s[2 * ks + 1][2], s[2 * ks + 1][3]); pb[ks] = __builtin_bit_cast(bf16x8, w); }
#pragma unroll
            for (int dt = 0; dt < 8; ++dt)
#pragma unroll
                for (int ks = 0; ks < 4; ++ks) { const bf16x8 a = *(const bf16x8*)(Vs + (16 * dt + fr) * RS + (32 * ks + 8 * g) * 2); o[dt] = MFMA16(a, pb[ks], o[dt]); }
            __syncthreads();
            if (c < c_hi) { lstore(); __syncthreads(); }
        }
        const float inv = 1.0f / lrun; float sq = 0.f;
#pragma unroll
        for (int dt = 0; dt < 8; ++dt) { const f32x4 v = o[dt] * inv; sq += (v[0] * v[0] + v[1] * v[1]) + (v[2] * v[2] + v[3] * v[3]);
            u32x2 w; w.x = pk2(v[0], v[1]); w.y = pk2(v[2], v[3]); *(u32x2*)(MIX + (size_t)tq * DM + hq * 128 + 16 * dt + 4 * g) = w; }
        sq += __shfl_xor(sq, 16); sq += __shfl_xor(sq, 32);
        if (g == 0) SSQA[(size_t)tq * 12 + hq] = sq;
    }
}
__device__ __forceinline__ void f1_phase(const Args& A) {
    const int tid = threadIdx.x, lane = tid & 63, wid = tid >> 6, fr = lane & 15, g = lane >> 4;
    const bf16* UP = (const bf16*)(A.ws + WS_UP); const bf16* W64 = (const bf16*)(A.ws + WS_W64); bf16* YB = (bf16*)(A.ws + WS_YB);
    const int gw = blockIdx.x * NWAVES + wid, NGW = gridDim.x * NWAVES;
    bf16x8 bfr[8][2];
#pragma unroll
    for (int nt = 0; nt < 8; ++nt)
#pragma unroll
        for (int kk = 0; kk < 2; ++kk) bfr[nt][kk] = *(const bf16x8*)(W64 + (16 * nt + fr) * 64 + 32 * kk + 8 * g);
    for (int rt = gw; rt < 4096; rt += NGW) {
        const int R0 = rt * 16, ch = R0 >> 7, s20 = R0 & 127;
        bf16x8 a[2];
#pragma unroll
        for (int kk = 0; kk < 2; ++kk) a[kk] = *(const bf16x8*)(UP + (size_t)(R0 + fr) * 64 + 32 * kk + 8 * g);
        f32x4 d[8];
#pragma unroll
        for (int nt = 0; nt < 8; ++nt) { d[nt] = (f32x4){0.f, 0.f, 0.f, 0.f};
#pragma unroll
            for (int kk = 0; kk < 2; ++kk) d[nt] = MFMA16(a[kk], bfr[nt][kk], d[nt]); }
#pragma unroll
        for (int nt = 0; nt < 4; ++nt) { const int k1 = 16 * nt + fr; float pr[4], pi[4];
#pragma unroll
            for (int r = 0; r < 4; ++r) { const int s2 = s20 + 4 * g + r; float sn, cs; sincospif((float)(s2 * k1) * (1.0f / 4096.0f), &sn, &cs);
                const float yr = d[nt][r], yi = d[nt + 4][r]; pr[r] = yr * cs + yi * sn; pi[r] = yi * cs - yr * sn; }
            bf16* dst = YB + (size_t)(ch * 64 + k1) * 256 + s20 + 4 * g;
            u32x2 w; w.x = pk2(pr[0], pr[1]); w.y = pk2(pr[2], pr[3]); *(u32x2*)dst = w;
            w.x = pk2(pi[0], pi[1]); w.y = pk2(pi[2], pi[3]); *(u32x2*)(dst + 128) = w; }
    }
}
__device__ __forceinline__ void f3_phase(const Args& A, unsigned char* lds) {
    const int tid = threadIdx.x, lane = tid & 63, wid = tid >> 6, fr = lane & 15, g = lane >> 4;
    const bf16* YB = (const bf16*)(A.ws + WS_YB); const bf16* BT3 = (const bf16*)(A.ws + WS_BT3); bf16* VB = (bf16*)(A.ws + WS_VB);
    constexpr int RS = 528;
    for (int i = 0; i < 16; ++i) { const int p = tid + 512 * i, row = p >> 5, c16 = p & 31; *(u32x4*)(lds + row * RS + c16 * 16) = *(const u32x4*)(BT3 + row * 256 + c16 * 8); }
    __syncthreads();
    for (int blk = blockIdx.x; blk < 256; blk += gridDim.x) {
        const int rt = blk * 8 + wid, k1 = rt >> 5, ch0 = (rt & 31) * 16;
        const bf16* ap = YB + (size_t)((ch0 + fr) * 64 + k1) * 256 + 8 * g;
        bf16x8 a[8];
#pragma unroll
        for (int kk = 0; kk < 8; ++kk) a[kk] = *(const bf16x8*)(ap + 32 * kk);
        const int grp = ch0 >> 7, cb = (ch0 & 127) + 4 * g;
#pragma unroll 4
        for (int nt = 0; nt < 16; ++nt) { f32x4 d = (f32x4){0.f, 0.f, 0.f, 0.f};
#pragma unroll
            for (int kk = 0; kk < 8; ++kk) { const bf16x8 b = *(const bf16x8*)(lds + (16 * nt + fr) * RS + (32 * kk + 8 * g) * 2); d = MFMA16(a[kk], b, d); }
            const int jc = 16 * nt + fr, k2 = jc & 127, im = jc >> 7, sp = k1 + 64 * k2;
            u32x2 w; w.x = pk2(d[0], d[1]); w.y = pk2(d[2], d[3]); *(u32x2*)(VB + (size_t)sp * 1024 + grp * 256 + im * 128 + cb) = w; }
    }
    __syncthreads();
}
__device__ __forceinline__ void f4_phase(const Args& A, unsigned char* lds) {
    const int tid = threadIdx.x, lane = tid & 63, wid = tid >> 6, fr = lane & 15, g = lane >> 4;
    const bf16* VB = (const bf16*)(A.ws + WS_VB); const bf16* WCS = (const bf16*)(A.ws + WS_WCS); bf16* MIX = (bf16*)(A.ws + WS_MIX);
    const float* SSQA = (const float*)(A.ws + WS_SSQA); float* RSA = (float*)(A.ws + WS_RSA);
    float* P = (float*)lds;
    const int g4 = wid & 3, half = wid >> 2;
    for (int blk = blockIdx.x; blk < 256; blk += gridDim.x) {
        const int sp = blk * 32 + half * 16 + fr;
        bf16x8 b[8];
#pragma unroll
        for (int kk = 0; kk < 8; ++kk) b[kk] = *(const bf16x8*)(VB + (size_t)sp * 1024 + g4 * 256 + 32 * kk + 8 * g);
        f32x4 o[8]; float sq = 0.f;
#pragma unroll
        for (int dt = 0; dt < 8; ++dt) { o[dt] = (f32x4){0.f, 0.f, 0.f, 0.f};
#pragma unroll
            for (int kk = 0; kk < 8; ++kk) { const bf16x8 a = *(const bf16x8*)(WCS + (size_t)(g4 * 128 + 16 * dt + fr) * 256 + 32 * kk + 8 * g); o[dt] = MFMA16(a, b[kk], o[dt]); }
            sq += (o[dt][0] * o[dt][0] + o[dt][1] * o[dt][1]) + (o[dt][2] * o[dt][2] + o[dt][3] * o[dt][3]); }
        sq += __shfl_xor(sq, 16); sq += __shfl_xor(sq, 32);
        if (g == 0) P[(half * 16 + fr) * 4 + g4] = sq;
        __syncthreads();
        const float* pp = P + (half * 16 + fr) * 4; const float tot = (pp[0] + pp[1]) + (pp[2] + pp[3]);
        const float rsf = 1.0f / sqrtf(tot * (1.0f / 512.0f) + RMS_EPS);
        float sa = 0.f;
#pragma unroll
        for (int h = 0; h < 12; ++h) sa += SSQA[(size_t)sp * 12 + h];
        const float rsa = 1.0f / sqrtf(sa * (1.0f / 1536.0f) + RMS_EPS);
        const float sc = rsf / rsa;
#pragma unroll
        for (int dt = 0; dt < 8; ++dt) { u32x2 w; w.x = pk2(o[dt][0] * sc, o[dt][1] * sc); w.y = pk2(o[dt][2] * sc, o[dt][3] * sc); *(u32x2*)(MIX + (size_t)sp * DM + NQ + g4 * 128 + 16 * dt + 4 * g) = w; }
        if (g4 == 0 && g == 0) RSA[sp] = rsa;
        __syncthreads();
    }
}
__device__ __forceinline__ void fixup_phase(const Args& A) {
    const float* edge = (const float*)(A.ws + WS_EDGE); const float* dww = A.in[10]; bf16* ACT = (bf16*)(A.ws + WS_ACT);
    const int gt = blockIdx.x * NTHREADS + threadIdx.x, NGT = gridDim.x * NTHREADS;
    for (int i = gt; i < 64 * (DFF / 4); i += NGT) { const int pe = i / (DFF / 4), c = (i % (DFF / 4)) * 4, pm = pe >> 1, e = pe & 1;
        const float* eb = edge + (size_t)(pe * 3) * DFF + c;
        f32x4 gp = *(const f32x4*)eb; const f32x4 V = *(const f32x4*)(eb + DFF);
        if (e == 0 && pm > 0) { const f32x4 G = *(const f32x4*)(edge + (size_t)(((pm - 1) * 2 + 1) * 3 + 2) * DFF + c); gp += *(const f32x4*)(dww + c) * G; }
        if (e == 1 && pm < 31) { const f32x4 G = *(const f32x4*)(edge + (size_t)(((pm + 1) * 2 + 0) * 3 + 2) * DFF + c); gp += *(const f32x4*)(dww + 2 * DFF + c) * G; }
        const pg8::f32x2 g0 = pg8::gelu_pk((pg8::f32x2){gp[0], gp[1]}), g1 = pg8::gelu_pk((pg8::f32x2){gp[2], gp[3]});
        const int row = 256 * pm + (e ? 255 : 0);
        u32x2 w; w.x = pk2(g0.x * V[0], g0.y * V[1]); w.y = pk2(g1.x * V[2], g1.y * V[3]); *(u32x2*)(ACT + (size_t)row * DFF + c) = w; }
}
__device__ __forceinline__ void final_phase(const Args& A) {
    const int tid = threadIdx.x, lane = tid & 63, wave = tid >> 6; const int gw = blockIdx.x * NWAVES + wave, NGW = gridDim.x * NWAVES;
    const float* SSQ2 = (const float*)(A.ws + WS_SSQ2); const float* ng = A.in[13];
    for (int m = gw; m < SEQ; m += NGW) {
        const f32x4 a = *(const f32x4*)(SSQ2 + (size_t)m * 8), b = *(const f32x4*)(SSQ2 + (size_t)m * 8 + 4);
        const float t = ((a[0] + a[1]) + (a[2] + a[3])) + ((b[0] + b[1]) + (b[2] + b[3])); const float rs = 1.0f / sqrtf(t * (1.0f / DM) + RMS_EPS);
        f32x4* xr = (f32x4*)(A.out + (size_t)m * DM) + lane; const f32x4* gr = (const f32x4*)ng + lane;
#pragma unroll
        for (int j = 0; j < 8; ++j) { const f32x4 v = xr[64 * j]; xr[64 * j] = v * rs * gr[64 * j]; }
    }
}

constexpr int NPHASE = 10;
__global__ void __launch_bounds__(NTHREADS, 2) fwd_mega(Args A) {
    extern __shared__ __attribute__((aligned(16))) unsigned char lds[];
    LAS unsigned char* ldsl = (LAS unsigned char*)lds;
    cg::grid_group grid = cg::this_grid();
    const int lo = A.ph_lo, hi = A.ph_hi;
#ifndef ONLY
#define ONLY -1
#endif
#define IN(k) ((ONLY < 0 || ONLY == (k)) && lo <= (k) && (k) < hi)
#define SEAM(k) do { if (IN(k) && IN((k) + 1)) grid.sync(); } while (0)
    unsigned char* ws = A.ws;
    const bf16* XB = (const bf16*)(ws + WS_XB); const float* RS1 = (const float*)(ws + WS_RS1);
    if (IN(0)) { p0_prologue(A, lds); } SEAM(0);
    if (IN(1)) {
        { pg8::Gemm gm{XB, (const bf16*)(ws + WS_WIN), SEQ, 2048, DM, 0}; pg8::StaticOrder S; S.init(SEQ, 2048, gridDim.x, blockIdx.x);
          pg8::EpiQK E{(bf16*)(ws + WS_Q), (bf16*)(ws + WS_K), RS1, 0.08838834764831845f * 1.4426950408889634f};
          pg8::gemm_phase<pg8::EpiQK, pg8::StaticOrder, true, true>(ldsl, gm, S, E); }
        { pg8::Gemm gm{(const bf16*)(ws + WS_WIN) + (size_t)2048 * DM, XB, 512, SEQ, DM, 0}; pg8::StaticOrder S; S.init(512, SEQ, gridDim.x, blockIdx.x);
          pg8::EpiVT E{(bf16*)(ws + WS_VT), RS1};
          pg8::gemm_phase<pg8::EpiVT, pg8::StaticOrder, true, true>(ldsl, gm, S, E); }
        { pg8::Gemm gm{(const bf16*)(ws + WS_WIN) + (size_t)2560 * DM, XB, 512, SEQ, DM, 1}; pg8::StaticOrder S; S.init(512, SEQ, gridDim.x, (int)((blockIdx.x + gridDim.x - 64) % gridDim.x));
          pg8::EpiUP E{(bf16*)(ws + WS_UP), RS1};
          pg8::gemm_phase<pg8::EpiUP, pg8::StaticOrder, true, true>(ldsl, gm, S, E); }
    } SEAM(1);
    if (IN(2)) { attn_phase(A, lds); f1_phase(A); } SEAM(2);
    if (IN(3)) { f3_phase(A, lds); } SEAM(3);
    if (IN(4)) { f4_phase(A, lds); } SEAM(4);
    if (IN(5)) {
        pg8::Gemm gm{(const bf16*)(ws + WS_MIX), (const bf16*)(ws + WS_WOUT), SEQ, DM, DM, 0}; pg8::StaticOrder S; S.init(SEQ, DM, gridDim.x, blockIdx.x);
        pg8::EpiRes E{A.in[0], A.out, (bf16*)(ws + WS_X1B), (const float*)(ws + WS_RSA), (float*)(ws + WS_SSQ1), ldsl + SCR_OFF};
        pg8::gemm_phase<pg8::EpiRes, pg8::StaticOrder, true, true>(ldsl, gm, S, E);
    } SEAM(5);
    if (IN(6)) {
        pg8::Gemm gm{(const bf16*)(ws + WS_X1B), (const bf16*)(ws + WS_WUP), SEQ, NUP, DM, 0}; pg8::StaticOrder S; S.init(SEQ, NUP, gridDim.x, blockIdx.x);
        pg8::EpiUp E{(bf16*)(ws + WS_ACT), (const float*)(ws + WS_SSQ1), A.in[10], A.in[11], (float*)(ws + WS_EDGE), ldsl + SCR_OFF};
        pg8::gemm_phase<pg8::EpiUp, pg8::StaticOrder, true, true>(ldsl, gm, S, E);
    } SEAM(6);
    if (IN(7)) { fixup_phase(A); } SEAM(7);
    if (IN(8)) {
        pg8::Gemm gm{(const bf16*)(ws + WS_ACT), (const bf16*)(ws + WS_WDOWN), SEQ, DM, DFF, 0}; pg8::StaticOrder S; S.init(SEQ, DM, gridDim.x, blockIdx.x);
        pg8::EpiRes E{A.out, A.out, nullptr, nullptr, (float*)(ws + WS_SSQ2), ldsl + SCR_OFF};
        pg8::gemm_phase<pg8::EpiRes, pg8::StaticOrder, true, true>(ldsl, gm, S, E);
    } SEAM(8);
    if (IN(9)) { final_phase(A); }
#undef IN
#undef SEAM
}

#ifndef MK_PER_PHASE
#define MK_PER_PHASE 0
#endif
extern "C" void kernel_launch(void* const* d_in, const int* in_sizes, int n_in, void* d_out, int out_size, void* d_ws, size_t ws_size, hipStream_t stream) {
    static int grid = 0;
    if (grid == 0) {
        if (n_in != 14 || out_size != SEQ * DM || ws_size < WS_END) { fprintf(stderr, "kernel_launch: unexpected shapes (n_in %d out %d ws %zu)\n", n_in, out_size, ws_size); grid = -1; return; }
        int dev = 0, cus = 0, per_cu = 0;
        (void)hipGetDevice(&dev); (void)hipDeviceGetAttribute(&cus, hipDeviceAttributeMultiprocessorCount, dev);
        (void)hipFuncSetAttribute((const void*)fwd_mega, hipFuncAttributeMaxDynamicSharedMemorySize, LDS_BYTES);
        if (hipOccupancyMaxActiveBlocksPerMultiprocessor(&per_cu, (const void*)fwd_mega, NTHREADS, LDS_BYTES) != hipSuccess || per_cu < 1) per_cu = 1;
        (void)hipGetLastError();
        grid = cus * 1;
        if (grid <= 0) grid = 256;
    }
    if (grid < 0) return;
    Args a{};
    for (int i = 0; i < 14; ++i) a.in[i] = (const float*)d_in[i];
    a.out = (float*)d_out; a.ws = (unsigned char*)d_ws;
#if MK_PER_PHASE
    for (int p = 0; p < NPHASE; ++p) { a.ph_lo = p; a.ph_hi = p + 1; hipLaunchKernelGGL(fwd_mega, dim3(grid), dim3(NTHREADS), LDS_BYTES, stream, a); }
#else
    a.ph_lo = 0; a.ph_hi = NPHASE;
    void* args[] = {&a};
    hipError_t e = hipLaunchCooperativeKernel((const void*)fwd_mega, dim3(grid), dim3(NTHREADS), args, LDS_BYTES, stream);
    if (e != hipSuccess) fprintf(stderr, "cooperative launch failed: %s (grid %d)\n", hipGetErrorString(e), grid);
#endif
}
```

```cpp
#include <hip/hip_runtime.h>
#include <hip/hip_cooperative_groups.h>
#include <cstdio>
#include <cstdint>
namespace cg = cooperative_groups;
namespace pg8 {
#define PG8_LAS __attribute__((address_space(3)))
typedef unsigned short bf16_t;
typedef short bf16x8 __attribute__((ext_vector_type(8)));
typedef float f32x4 __attribute__((ext_vector_type(4)));
typedef unsigned u32x4 __attribute__((ext_vector_type(4)));
constexpr int BM = 256, BK = 64, HALF = 128, HTB = HALF * BK * 2  , STAGE_BYTES = 8 * HTB, NXCD = 8, WGM = 8;

__host__ __device__ __forceinline__ int lds_byte(int r, int c) { const int st = (r >> 4) * 2 + (c >> 5), rr = r & 15, cc = c & 31, ob = rr * 64 + cc * 2; return st * 1024 + (ob ^ (((ob >> 9) & 1) << 5)); }
__host__ __device__ __forceinline__ void stage_rc(int b, int& R, int& C) { const int st = b / 1024, sb = b % 1024, swz = sb ^ (((sb >> 9) & 1) << 5); R = (st >> 1) * 16 + swz / 64; C = (st & 1) * 32 + (swz % 64) / 2; }
__host__ __device__ __forceinline__ int perm32(int rho) { const int n = rho >> 4, i = rho & 15; return 8 * (i >> 2) + 4 * n + (i & 3); }

struct Unit { int pm, pn; };
struct Gemm { const bf16_t* A; const bf16_t* Bt; int M, N, K; int bmode; };

struct StaticOrder {
    int nM, nN, nwg, G, c;
    __host__ __device__ void init(int M, int N, int G_, int c_) { nM = M / BM; nN = N / BM; nwg = nM * nN; G = G_; c = c_; }
    __host__ __device__ bool next(int i, Unit& u) const {
        const long L = (long)i * G + c; if (L >= nwg) return false;
        int wgid = (int)L; { const int q = nwg / NXCD, r = nwg % NXCD, xcd = wgid % NXCD, off = wgid / NXCD; wgid = (xcd < r ? xcd * (q + 1) : r * (q + 1) + (xcd - r) * q) + off; }
        const int nig = WGM * nN, gid = wgid / nig, fm = gid * WGM, gsz = (nM - fm) < WGM ? (nM - fm) : WGM;
        u.pm = fm + ((wgid % nig) % gsz); u.pn = (wgid % nig) / gsz; return true;
    }
    __device__ __forceinline__ void a_ready(const Unit&) const {}
    __device__ __forceinline__ void done(const Unit&) const {}
};

__device__ __forceinline__ unsigned cvt_pk_bf16(float lo, float hi) { unsigned r; asm volatile("v_cvt_pk_bf16_f32 %0, %1, %2" : "=v"(r) : "v"(lo), "v"(hi)); return r; }
typedef float f32x2 __attribute__((ext_vector_type(2)));
typedef unsigned u32x2 __attribute__((ext_vector_type(2)));
__device__ __forceinline__ f32x2 gelu_pk(f32x2 v) {
    const f32x2 av = __builtin_elementwise_abs(v), d = av * 0.2316418882f + 1.0f;
    f32x2 t; t.x = __builtin_amdgcn_rcpf(d.x); t.y = __builtin_amdgcn_rcpf(d.y);
    f32x2 q = t * 0.5307027145f + (-0.7265760135f); q = q * t + 0.7107068705f; q = q * t + (-0.142248368f); q = q * t + 0.127414796f; q = q * t;
    const f32x2 s = (v * v) * (-0.72134752044f);
    f32x2 e; e.x = __builtin_amdgcn_exp2f(s.x); e.y = __builtin_amdgcn_exp2f(s.y);
    const f32x2 m = v * (q * e), r = v - m;
    f32x2 o; o.x = v.x < 0.f ? m.x : r.x; o.y = v.y < 0.f ? m.y : r.y; return o;
}
#define EPI_BAR() do { asm volatile("s_waitcnt lgkmcnt(0)" ::: "memory"); __builtin_amdgcn_s_barrier(); asm volatile("" ::: "memory"); } while (0)
constexpr float RMS_EPS = 1e-6f;

struct EpiQK {
    static constexpr bool PERM = true, AFTER_DRAIN = false;
    bf16_t* Q; bf16_t* Kb; const float* rs1; float qscale;
    __device__ __forceinline__ void operator()(f32x4 (&acc)[2][2][4][2], const Unit& u, int wr, int wc, int fr, int fq) const {
        const int row0 = u.pm * BM + wr * 64 + fr; const int colt = u.pn * BM;
        bf16_t* base; int ldc; float sc;
        if (colt < 1536) { base = Q + colt; ldc = 1536; sc = qscale; } else { base = Kb + (colt - 1536); ldc = 512; sc = 1.f; }
        const int col0 = wc * 32 + 8 * fq;
#pragma unroll
        for (int ai = 0; ai < 2; ++ai)
#pragma unroll
            for (int m = 0; m < 4; ++m) { const int row = row0 + ai * HALF + m * 16; const float s = rs1[row] * sc; bf16_t* rowp = base + (size_t)row * ldc + col0;
#pragma unroll
                for (int bj = 0; bj < 2; ++bj) { const f32x4 v0 = acc[ai][bj][m][0] * s, v1 = acc[ai][bj][m][1] * s;
                    u32x4 w; w.x = cvt_pk_bf16(v0[0], v0[1]); w.y = cvt_pk_bf16(v0[2], v0[3]); w.z = cvt_pk_bf16(v1[0], v1[1]); w.w = cvt_pk_bf16(v1[2], v1[3]);
                    *(u32x4*)(rowp + bj * HALF) = w; } }
    }
};
struct EpiVT {
    static constexpr bool PERM = false, AFTER_DRAIN = false;
    bf16_t* O; const float* rs1;
    __device__ __forceinline__ void operator()(f32x4 (&acc)[2][2][4][2], const Unit& u, int wr, int wc, int fr, int fq) const {
        const int row0 = u.pm * BM + wr * 64 + fr;
#pragma unroll
        for (int bj = 0; bj < 2; ++bj) {
            const int tok0 = u.pn * BM + bj * HALF + wc * 32 + 4 * fq;
            const f32x4 s0 = *(const f32x4*)(rs1 + tok0), s1 = *(const f32x4*)(rs1 + tok0 + 16);
            const int pos0 = u.pn * BM + bj * HALF + wc * 32 + 8 * fq;
#pragma unroll
            for (int ai = 0; ai < 2; ++ai)
#pragma unroll
                for (int m = 0; m < 4; ++m) { const int row = row0 + ai * HALF + m * 16; const f32x4 v0 = acc[ai][bj][m][0] * s0, v1 = acc[ai][bj][m][1] * s1;
                    u32x4 w; w.x = cvt_pk_bf16(v0[0], v0[1]); w.y = cvt_pk_bf16(v0[2], v0[3]); w.z = cvt_pk_bf16(v1[0], v1[1]); w.w = cvt_pk_bf16(v1[2], v1[3]);
                    *(u32x4*)(O + (size_t)row * 8192 + pos0) = w; }
        }
    }
};
struct EpiUP {
    static constexpr bool PERM = true, AFTER_DRAIN = false;
    bf16_t* O; const float* rs1;
    __device__ __forceinline__ void operator()(f32x4 (&acc)[2][2][4][2], const Unit& u, int wr, int wc, int fr, int fq) const {
        const int row0 = u.pm * BM + wr * 64 + fr;
#pragma unroll
        for (int bj = 0; bj < 2; ++bj) {
            const int s2 = 4 * u.pn + 2 * bj + (wc >> 1); const int s1b = 32 * (wc & 1) + 8 * fq;
            float sc[8];
#pragma unroll
            for (int e = 0; e < 8; ++e) sc[e] = rs1[128 * (s1b + e) + s2];
            const int pos0 = u.pn * BM + bj * HALF + wc * 32 + 8 * fq;
#pragma unroll
            for (int ai = 0; ai < 2; ++ai)
#pragma unroll
                for (int m = 0; m < 4; ++m) { const int row = row0 + ai * HALF + m * 16; const f32x4 v0 = acc[ai][bj][m][0], v1 = acc[ai][bj][m][1];
                    u32x4 w; w.x = cvt_pk_bf16(v0[0] * sc[0], v0[1] * sc[1]); w.y = cvt_pk_bf16(v0[2] * sc[2], v0[3] * sc[3]); w.z = cvt_pk_bf16(v1[0] * sc[4], v1[1] * sc[5]); w.w = cvt_pk_bf16(v1[2] * sc[6], v1[3] * sc[7]);
                    *(u32x4*)(O + (size_t)row * 8192 + pos0) = w; }
        }
    }
};
struct EpiRes {
    static constexpr bool PERM = false, AFTER_DRAIN = false;
    const float* base; float* out; bf16_t* outb; const float* rowscale; float* ssq; PG8_LAS unsigned char* scr;
    __device__ __forceinline__ void operator()(f32x4 (&acc)[2][2][4][2], const Unit& u, int wr, int wc, int fr, int fq) const {
        const int col0 = u.pn * BM + wc * 32 + 4 * fq;
        PG8_LAS float* P = (PG8_LAS float*)scr;
#pragma unroll
        for (int ai = 0; ai < 2; ++ai)
#pragma unroll
            for (int m = 0; m < 4; ++m) { const int r = ai * HALF + wr * 64 + m * 16 + fr; const int row = u.pm * BM + r; const float sc = rowscale ? rowscale[row] : 1.f; float s = 0.f;
#pragma unroll
                for (int bj = 0; bj < 2; ++bj)
#pragma unroll
                    for (int n = 0; n < 2; ++n) { const size_t off = (size_t)row * 2048 + col0 + bj * HALF + n * 16; const f32x4 b = *(const f32x4*)(base + off); const f32x4 o = b + acc[ai][bj][m][n] * sc;
                        *(f32x4*)(out + off) = o; s += (o[0] * o[0] + o[1] * o[1]) + (o[2] * o[2] + o[3] * o[3]);
                        if (outb) { u32x2 w; w.x = cvt_pk_bf16(o[0], o[1]); w.y = cvt_pk_bf16(o[2], o[3]); *(u32x2*)(outb + off) = w; } }
                s += __shfl_xor(s, 16); s += __shfl_xor(s, 32);
                if (fq == 0) P[r * 4 + wc] = s; }
        EPI_BAR();
        const int tid = threadIdx.x;
        if (tid < 256) { const f32x4 p = *(const PG8_LAS f32x4*)(P + tid * 4); ssq[(size_t)(u.pm * BM + tid) * 8 + u.pn] = (p[0] + p[1]) + (p[2] + p[3]); }
    }
};
struct EpiUp {
    static constexpr bool PERM = false, AFTER_DRAIN = false;
    bf16_t* act; const float* ssq1; const float* dww; const float* dwb; float* edge; PG8_LAS unsigned char* scr;
    __device__ __forceinline__ void operator()(f32x4 (&acc)[2][2][4][2], const Unit& u, int wr, int wc, int fr, int fq) const {
        const int lane = threadIdx.x & 63;
#pragma unroll
        for (int ai = 0; ai < 2; ++ai)
#pragma unroll
            for (int m = 0; m < 4; ++m) { const int row = u.pm * BM + ai * HALF + wr * 64 + m * 16 + fr; const f32x4 a = *(const f32x4*)(ssq1 + (size_t)row * 8), b = *(const f32x4*)(ssq1 + (size_t)row * 8 + 4);
                const float t = ((a[0] + a[1]) + (a[2] + a[3])) + ((b[0] + b[1]) + (b[2] + b[3])); const float rs = 1.0f / sqrtf(t * (1.0f / 2048.0f) + RMS_EPS);
#pragma unroll
                for (int bj = 0; bj < 2; ++bj)
#pragma unroll
                    for (int n = 0; n < 2; ++n) acc[ai][bj][m][n] *= rs; }
        PG8_LAS float* halo = (PG8_LAS float*)scr;
        const int cl = 32 * wc + 4 * fq;
#pragma unroll
        for (int ai = 0; ai < 2; ++ai) { const int seg = 2 * ai + wr;
            if (fr == 0) {
#pragma unroll
                for (int n = 0; n < 2; ++n) *(PG8_LAS f32x4*)(halo + (seg * 2 + 0) * 128 + cl + 16 * n) = acc[ai][0][0][n]; }
            if (fr == 15) {
#pragma unroll
                for (int n = 0; n < 2; ++n) *(PG8_LAS f32x4*)(halo + (seg * 2 + 1) * 128 + cl + 16 * n) = acc[ai][0][3][n]; } }
        EPI_BAR();
        const int c0 = 128 * u.pn + cl;
        const int src_up = (lane & 48) | ((fr + 15) & 15), src_dn = (lane & 48) | ((fr + 1) & 15);
#pragma unroll
        for (int n = 0; n < 2; ++n) {
            const f32x4 w0 = *(const f32x4*)(dww + c0 + 16 * n), w1 = *(const f32x4*)(dww + 5504 + c0 + 16 * n), w2 = *(const f32x4*)(dww + 11008 + c0 + 16 * n), bb = *(const f32x4*)(dwb + c0 + 16 * n);
#pragma unroll
            for (int ai = 0; ai < 2; ++ai) { const int seg = 2 * ai + wr;
                f32x4 hu = (f32x4){0.f, 0.f, 0.f, 0.f}, hd = (f32x4){0.f, 0.f, 0.f, 0.f};
                if (seg > 0) hu = *(const PG8_LAS f32x4*)(halo + ((seg - 1) * 2 + 1) * 128 + cl + 16 * n);
                if (seg < 3) hd = *(const PG8_LAS f32x4*)(halo + ((seg + 1) * 2 + 0) * 128 + cl + 16 * n);
#pragma unroll
                for (int m = 0; m < 4; ++m) {
                    const f32x4 G = acc[ai][0][m][n];
                    f32x4 xu = G, xd = G;
                    if (m > 0 && fr == 15) xu = acc[ai][0][m - 1][n];
                    if (m < 3 && fr == 0) xd = acc[ai][0][m + 1][n];
                    f32x4 U, D;
#pragma unroll
                    for (int e = 0; e < 4; ++e) { U[e] = __shfl(xu[e], src_up); D[e] = __shfl(xd[e], src_dn); }
                    if (m == 0 && fr == 0) U = hu;
                    if (m == 3 && fr == 15) D = hd;
                    const f32x4 gp = w0 * U + w1 * G + w2 * D + bb;
                    const f32x4 V = acc[ai][1][m][n];
                    const f32x2 g0 = gelu_pk((f32x2){gp[0], gp[1]}), g1 = gelu_pk((f32x2){gp[2], gp[3]});
                    const int row = u.pm * BM + ai * HALF + wr * 64 + m * 16 + fr;
                    u32x2 w; w.x = cvt_pk_bf16(g0.x * V[0], g0.y * V[1]); w.y = cvt_pk_bf16(g1.x * V[2], g1.y * V[3]);
                    *(u32x2*)(act + (size_t)row * 5504 + c0 + 16 * n) = w;
                    if (ai == 0 && m == 0 && wr == 0 && fr == 0) { float* e0 = edge + (size_t)((u.pm * 2 + 0) * 3) * 5504 + c0 + 16 * n;
                        *(f32x4*)(e0) = gp; *(f32x4*)(e0 + 5504) = V; *(f32x4*)(e0 + 2 * 5504) = G; }
                    if (ai == 1 && m == 3 && wr == 1 && fr == 15) { float* e1 = edge + (size_t)((u.pm * 2 + 1) * 3) * 5504 + c0 + 16 * n;
                        *(f32x4*)(e1) = gp; *(f32x4*)(e1 + 5504) = V; *(f32x4*)(e1 + 2 * 5504) = G; }
                }
            }
        }
    }
};
template <class Epi, class Sched, bool ALIGN_EPI = false, bool SP2 = false>
__device__ __forceinline__ void gemm_phase(PG8_LAS unsigned char* lds, const Gemm g, const Sched& S, const Epi& E) {
    const int tid = threadIdx.x, wid = __builtin_amdgcn_readfirstlane(tid >> 6), lane = tid & 63, wr = wid >> 2, wc = wid & 3, fr = lane & 15, fq = lane >> 4;
    const int K = g.K, nt = K / BK;
    unsigned voffA[2], voffB[2];
#pragma unroll
    for (int i = 0; i < 2; ++i) { int R, C; stage_rc(tid * 16 + i * 8192, R, C); const int Rb = Epi::PERM ? ((R & ~31) + perm32(R & 31)) : R;
        voffA[i] = (unsigned)(R * K + C) * 2u; voffB[i] = g.bmode ? (unsigned)(((Rb & 63) * 128 + (Rb >> 6)) * K + C) * 2u : (unsigned)(Rb * K + C) * 2u; }
    const size_t kstep = (size_t)(BK * 2);
    const size_t hstepA = (size_t)HALF * K * 2; const size_t hstepB = g.bmode ? (size_t)2 * K * 2 : hstepA;
    const size_t tstepA = 2 * hstepA; const size_t tstepB = 2 * hstepB;
    const unsigned ldsw = (unsigned)wid * 1024u;
    const int aoff = lds_byte(wr * 64 + fr, fq * 8), boff = lds_byte(wc * 32 + fr, fq * 8);
#define PG8_SA(b, h) (((b) * 2 + (h)) * HTB)
#define PG8_SB(b, h) ((4 + (b) * 2 + (h)) * HTB)
#define PG8_STAGE(bufoff, gbase, voff) do { _Pragma("unroll") for (int _i = 0; _i < 2; ++_i) \
        __builtin_amdgcn_global_load_lds((const unsigned*)((const char*)(gbase) + (voff)[_i]), (PG8_LAS unsigned*)(lds + (bufoff) + ldsw + _i * 8192), 16, 0, 0); } while (0)
#define PG8_LDA(dst, b, h) do { _Pragma("unroll") for (int m = 0; m < 4; ++m) _Pragma("unroll") for (int k = 0; k < 2; ++k) dst[m][k] = *(const PG8_LAS bf16x8*)(lds + PG8_SA(b, h) + aoff + m * 2048 + k * 1024); } while (0)
#define PG8_LDB(dst, b, h) do { _Pragma("unroll") for (int n = 0; n < 2; ++n) _Pragma("unroll") for (int k = 0; k < 2; ++k) dst[n][k] = *(const PG8_LAS bf16x8*)(lds + PG8_SB(b, h) + boff + n * 2048 + k * 1024); } while (0)
#define PG8_MMA(ai, bj, At, Bt) do { __builtin_amdgcn_s_setprio(1); _Pragma("unroll") for (int m = 0; m < 4; ++m) _Pragma("unroll") for (int n = 0; n < 2; ++n) _Pragma("unroll") for (int k = 0; k < 2; ++k) \
        acc[ai][bj][m][n] = __builtin_amdgcn_mfma_f32_16x16x32_bf16(Bt[n][k], At[m][k], acc[ai][bj][m][n], 0, 0, 0); __builtin_amdgcn_s_setprio(0); } while (0)
#define PG8_WAIT_V(n) asm volatile("s_waitcnt vmcnt(" #n ")" ::: "memory")
#define PG8_WAIT_L(n) asm volatile("s_waitcnt lgkmcnt(" #n ")" ::: "memory")
#define PG8_BAR __builtin_amdgcn_s_barrier()
#define PG8_SCHED __builtin_amdgcn_sched_barrier(0)
    Unit cur, nxt; int ui = 0;
    if (!S.next(0, cur)) return;
    f32x4 acc[2][2][4][2];
#pragma unroll
    for (int a = 0; a < 2; ++a)
#pragma unroll
        for (int b = 0; b < 2; ++b)
#pragma unroll
            for (int m = 0; m < 4; ++m)
#pragma unroll
                for (int n = 0; n < 2; ++n) acc[a][b][m][n] = (f32x4){0.f, 0.f, 0.f, 0.f};
    bf16x8 At[4][2], B0[2][2], B1[2][2];
    const char* cA = (const char*)g.A + (size_t)cur.pm * tstepA; const char* cB = (const char*)g.Bt + (size_t)cur.pn * tstepB;
    S.a_ready(cur);
    if constexpr (SP2) {
        PG8_STAGE(PG8_SB(0, 0), cB, voffB); PG8_STAGE(PG8_SB(0, 1), cB + hstepB, voffB); PG8_STAGE(PG8_SA(0, 0), cA, voffA); PG8_STAGE(PG8_SA(0, 1), cA + hstepA, voffA);
        if (wr == 1) PG8_BAR;
        PG8_WAIT_V(2); PG8_BAR;
        PG8_STAGE(PG8_SB(1, 0), cB + kstep, voffB); PG8_STAGE(PG8_SA(1, 0), cA + kstep, voffA); PG8_STAGE(PG8_SB(1, 1), cB + hstepB + kstep, voffB);
        PG8_WAIT_V(6); PG8_BAR;
    } else {
        PG8_STAGE(PG8_SB(0, 0), cB, voffB); PG8_STAGE(PG8_SA(0, 0), cA, voffA); PG8_STAGE(PG8_SB(0, 1), cB + hstepB, voffB); PG8_STAGE(PG8_SA(0, 1), cA + hstepA, voffA);
        if (wr == 1) PG8_BAR;
        PG8_WAIT_V(4); PG8_BAR;
        PG8_STAGE(PG8_SB(1, 0), cB + kstep, voffB); PG8_STAGE(PG8_SA(1, 0), cA + kstep, voffA); PG8_STAGE(PG8_SB(1, 1), cB + hstepB + kstep, voffB);
        PG8_WAIT_V(6); PG8_BAR;
    }
    for (;;) {
        const bool has_next = S.next(ui + 1, nxt);
        const char* nA = has_next ? (const char*)g.A + (size_t)nxt.pm * tstepA : cA; const char* nB = has_next ? (const char*)g.Bt + (size_t)nxt.pn * tstepB : cB;
        for (int t = 0; t < nt; t += 2) {
            const bool last = (t == nt - 2);
            const char* a1 = cA + (size_t)(t + 1) * kstep;
            const char* a2 = last ? nA : cA + (size_t)(t + 2) * kstep; const char* b2 = last ? nB : cB + (size_t)(t + 2) * kstep;
            const char* a3 = a2 + kstep; const char* b3 = b2 + kstep;
            if (last && has_next) S.a_ready(nxt);
            if constexpr (SP2) {
            PG8_LDB(B0, 0, 0); PG8_LDB(B1, 0, 1); PG8_SCHED; PG8_LDA(At, 0, 0); PG8_STAGE(PG8_SA(1, 1), a1 + hstepA, voffA);
            PG8_WAIT_V(8); PG8_WAIT_L(0); PG8_BAR; PG8_MMA(0, 0, At, B0); PG8_MMA(0, 1, At, B1); PG8_BAR; PG8_SCHED;
            PG8_LDA(At, 0, 1); PG8_STAGE(PG8_SB(0, 0), b2, voffB); PG8_STAGE(PG8_SB(0, 1), b2 + hstepB, voffB); PG8_STAGE(PG8_SA(0, 0), a2, voffA);
            PG8_WAIT_V(8); PG8_WAIT_L(0); PG8_BAR; PG8_MMA(1, 0, At, B0); PG8_MMA(1, 1, At, B1); PG8_BAR; PG8_SCHED;
            PG8_LDB(B0, 1, 0); PG8_LDB(B1, 1, 1); PG8_SCHED; PG8_LDA(At, 1, 0); PG8_STAGE(PG8_SA(0, 1), a2 + hstepA, voffA);
            PG8_WAIT_V(8); PG8_WAIT_L(0); PG8_BAR; PG8_MMA(0, 0, At, B0); PG8_MMA(0, 1, At, B1); PG8_BAR; PG8_SCHED;
            PG8_LDA(At, 1, 1); PG8_STAGE(PG8_SB(1, 0), b3, voffB); PG8_STAGE(PG8_SB(1, 1), b3 + hstepB, voffB); PG8_STAGE(PG8_SA(1, 0), a3, voffA);
            PG8_WAIT_V(8); PG8_WAIT_L(0); PG8_BAR; PG8_MMA(1, 0, At, B0); PG8_MMA(1, 1, At, B1); PG8_BAR; PG8_SCHED;
            } else {
            PG8_LDB(B0, 0, 0); PG8_SCHED; PG8_LDA(At, 0, 0); PG8_STAGE(PG8_SA(1, 1), a1 + hstepA, voffA);
            PG8_WAIT_L(8); PG8_BAR; PG8_WAIT_L(0); PG8_MMA(0, 0, At, B0); PG8_BAR; PG8_SCHED;
            PG8_LDB(B1, 0, 1); PG8_STAGE(PG8_SB(0, 0), b2, voffB);
            PG8_BAR; PG8_WAIT_L(0); PG8_MMA(0, 1, At, B1); PG8_BAR;
            PG8_LDA(At, 0, 1); PG8_STAGE(PG8_SA(0, 0), a2, voffA);
            PG8_BAR; PG8_WAIT_L(0); PG8_MMA(1, 0, At, B0); PG8_BAR; PG8_SCHED;
            PG8_STAGE(PG8_SB(0, 1), b2 + hstepB, voffB);
            PG8_WAIT_V(6); PG8_BAR; PG8_MMA(1, 1, At, B1); PG8_BAR;
            PG8_LDB(B0, 1, 0); PG8_SCHED; PG8_LDA(At, 1, 0); PG8_STAGE(PG8_SA(0, 1), a2 + hstepA, voffA);
            PG8_WAIT_L(8); PG8_BAR; PG8_WAIT_L(0); PG8_MMA(0, 0, At, B0); PG8_BAR; PG8_SCHED;
            PG8_LDB(B1, 1, 1); PG8_STAGE(PG8_SB(1, 0), b3, voffB);
            PG8_BAR; PG8_WAIT_L(0); PG8_MMA(0, 1, At, B1); PG8_BAR;
            PG8_LDA(At, 1, 1); PG8_STAGE(PG8_SA(1, 0), a3, voffA);
            PG8_BAR; PG8_WAIT_L(0); PG8_MMA(1, 0, At, B0); PG8_BAR; PG8_SCHED;
            PG8_STAGE(PG8_SB(1, 1), b3 + hstepB, voffB);
            PG8_WAIT_V(6); PG8_BAR; PG8_MMA(1, 1, At, B1); PG8_BAR;
            }
        }
        if constexpr (ALIGN_EPI) { if (wr == 0) PG8_BAR; }
        if constexpr (!Epi::AFTER_DRAIN) { E(acc, cur, wr, wc, fr, fq); S.done(cur); }
        if (!has_next) break;
#pragma unroll
        for (int a = 0; a < 2; ++a)
#pragma unroll
            for (int b = 0; b < 2; ++b)
#pragma unroll
                for (int m = 0; m < 4; ++m)
#pragma unroll
                    for (int n = 0; n < 2; ++n) acc[a][b][m][n] = (f32x4){0.f, 0.f, 0.f, 0.f};
        cur = nxt; cA = nA; cB = nB; ++ui;
        if constexpr (ALIGN_EPI) { if (wr == 1) PG8_BAR; }
    }
    PG8_WAIT_V(0);
    if constexpr (!ALIGN_EPI) { if (wr == 0) PG8_BAR; }
    PG8_BAR;
    if constexpr (Epi::AFTER_DRAIN) { E.fused(acc, cur, wr, wc, fr, fq, lds, wid, lane); S.done(cur); }
#undef PG8_SA
#undef PG8_SB
#undef PG8_STAGE
#undef PG8_LDA
#undef PG8_LDB
#undef PG8_MMA
#undef PG8_WAIT_V
#undef PG8_WAIT_L
#undef PG8_BAR
#undef PG8_SCHED
}
}
constexpr int SEQ = 8192, DM = 2048, NQ = 1536, NKV = 512, NFO = 512, NIN = 3072, DFF = 5504, NUP = 11008;
using pg8::RMS_EPS;
constexpr size_t MiB = 1u << 20;
constexpr size_t WS_WIN = 0, WS_WOUT = 12 * MiB, WS_WUP = 20 * MiB, WS_WDOWN = 63 * MiB;
constexpr size_t WS_XB = 85 * MiB, WS_Q = 117 * MiB, WS_K = 141 * MiB, WS_VT = 149 * MiB, WS_UP = 157 * MiB, WS_MIX = 165 * MiB, WS_YB = 197 * MiB, WS_VB = 213 * MiB;
constexpr size_t WS_ACT = 85 * MiB;
constexpr size_t WS_SMALL = 229 * MiB;
constexpr size_t WS_RS1 = WS_SMALL, WS_RSA = WS_SMALL + 32768, WS_SSQA = WS_SMALL + 65536, WS_SSQ1 = WS_SMALL + 524288, WS_SSQ2 = WS_SMALL + 786432;
constexpr size_t WS_W64 = WS_SMALL + 1048576, WS_BT3 = WS_SMALL + 1114112, WS_WCS = WS_SMALL + 1310720, WS_EDGE = WS_SMALL + 2 * MiB;
constexpr size_t WS_CTL = WS_SMALL + 8 * MiB, CTL_BYTES = 16384;
constexpr size_t WS_X1B = 240 * MiB, WS_END = 272 * MiB;
static_assert(WS_ACT + (size_t)SEQ * DFF * 2 <= WS_YB + 16 * MiB && WS_EDGE + (size_t)64 * 3 * DFF * 4 <= WS_X1B, "ws map");
constexpr int RING_BYTES = 131072, SCR_OFF = RING_BYTES + 512, LDS_BYTES = 147456;
constexpr int NWAVES = 8, NTHREADS = 512;
#define LAS __attribute__((address_space(3)))
typedef unsigned short bf16;
typedef float f32x4 __attribute__((ext_vector_type(4)));
typedef short bf16x8 __attribute__((ext_vector_type(8)));
typedef unsigned u32x4 __attribute__((ext_vector_type(4)));
typedef unsigned u32x2 __attribute__((ext_vector_type(2)));
__device__ __forceinline__ unsigned f2bf(float f) { unsigned u = __builtin_bit_cast(unsigned, f); return (u + 0x7fffu + ((u >> 16) & 1u)) >> 16; }
__device__ __forceinline__ unsigned pk2(float lo, float hi) { return f2bf(lo) | (f2bf(hi) << 16); }
__device__ __forceinline__ float wave_sum(float v) {
#pragma unroll
    for (int o = 1; o < 64; o <<= 1) v += __shfl_xor(v, o);
    return v;
}
#define MFMA16(a, b, c) __builtin_amdgcn_mfma_f32_16x16x32_bf16((a), (b), (c), 0, 0, 0)

struct Args { const float* in[14]; float* out; unsigned char* ws; int ph_lo, ph_hi; };

__device__ __forceinline__ void p0_item(const float* W, int K, int N, bf16* WT, int out_row0, const float* ksc, float* scr, int k0, int n0, int lane) {
#pragma unroll 8
    for (int i = 0; i < 32; ++i) { const int kk = 2 * i + (lane >> 5); const float s = ksc ? ksc[k0 + kk] : 1.f; scr[kk * 33 + (lane & 31)] = W[(size_t)(k0 + kk) * N + n0 + (lane & 31)] * s; }
    asm volatile("s_waitcnt lgkmcnt(0)" ::: "memory");
    const int c = lane & 7;
#pragma unroll
    for (int j = 0; j < 4; ++j) { const int n = (lane >> 3) + 8 * j; const float* s = scr + (8 * c) * 33 + n;
        u32x4 o; o.x = pk2(s[0 * 33], s[1 * 33]); o.y = pk2(s[2 * 33], s[3 * 33]); o.z = pk2(s[4 * 33], s[5 * 33]); o.w = pk2(s[6 * 33], s[7 * 33]);
        *(u32x4*)(WT + (size_t)(out_row0 + n) * K + k0 + 8 * c) = o; }
    asm volatile("s_waitcnt lgkmcnt(0)" ::: "memory");
}
__device__ __forceinline__ void p0_prologue(const Args& A, unsigned char* lds) {
    const int tid = threadIdx.x, lane = tid & 63, wave = tid >> 6;
    const int gw = blockIdx.x * NWAVES + wave, NGW = gridDim.x * NWAVES;
    float* scr = (float*)(lds + wave * 16384);
    const float* x = A.in[0]; const float* n1g = A.in[1]; const float* w_in = A.in[2]; const float* w_four = A.in[4]; const float* ag = A.in[5]; const float* fg = A.in[6];
    const float* w_out = A.in[7]; const float* n2g = A.in[8]; const float* w_up = A.in[9]; const float* w_down = A.in[12];
    bf16* WIN = (bf16*)(A.ws + WS_WIN); bf16* WOUT = (bf16*)(A.ws + WS_WOUT); bf16* WUP = (bf16*)(A.ws + WS_WUP); bf16* WDOWN = (bf16*)(A.ws + WS_WDOWN);
    constexpr int I_IN = 32 * 96, I_OUT = 32 * 64, I_UP = 32 * 344, I_DOWN = 86 * 64, NITEMS = I_IN + I_OUT + I_UP + I_DOWN;
    for (int it = gw; it < NITEMS; it += NGW) {
        int r = it;
        if (r < I_IN) { const int kb = r / 96, nb = r % 96; p0_item(w_in, DM, NIN, WIN, 32 * nb, n1g, scr, 64 * kb, 32 * nb, lane); continue; } r -= I_IN;
        if (r < I_OUT) { const int kb = r / 64, nb = r % 64; const int k0 = 64 * kb; p0_item(w_out, DM, DM, WOUT, 32 * nb, k0 < NQ ? ag : fg - NQ, scr, k0, 32 * nb, lane); continue; } r -= I_OUT;
        if (r < I_UP) { const int kb = r / 344, nb = r % 344; const int n0 = 32 * nb; int orow; if (n0 < DFF) orow = 256 * (n0 >> 7) + (n0 & 127); else { const int c = n0 - DFF; orow = 256 * (c >> 7) + 128 + (c & 127); }
            p0_item(w_up, DM, NUP, WUP, orow, n2g, scr, 64 * kb, n0, lane); continue; } r -= I_UP;
        { const int kb = r / 64, nb = r % 64; p0_item(w_down, DFF, DM, WDOWN, 32 * nb, nullptr, scr, 64 * kb, 32 * nb, lane); }
    }
    bf16* XB = (bf16*)(A.ws + WS_XB); float* RS1 = (float*)(A.ws + WS_RS1);
    for (int m = gw; m < SEQ; m += NGW) {
        const f32x4* xr = (const f32x4*)(x + (size_t)m * DM) + lane; f32x4 v[8]; float s = 0.f;
#pragma unroll
        for (int j = 0; j < 8; ++j) { v[j] = xr[64 * j]; s += (v[j][0] * v[j][0] + v[j][1] * v[j][1]) + (v[j][2] * v[j][2] + v[j][3] * v[j][3]); }
        s = wave_sum(s);
        u32x2* o8 = (u32x2*)(XB + (size_t)m * DM) + lane;
#pragma unroll
        for (int j = 0; j < 8; ++j) { u32x2 w; w.x = pk2(v[j][0], v[j][1]); w.y = pk2(v[j][2], v[j][3]); o8[64 * j] = w; }
        if (lane == 0) RS1[m] = 1.0f / sqrtf(s * (1.0f / DM) + RMS_EPS);
    }
    const int gt = blockIdx.x * NTHREADS + tid, NGT = gridDim.x * NTHREADS;
    bf16* W64 = (bf16*)(A.ws + WS_W64); bf16* BT3 = (bf16*)(A.ws + WS_BT3); bf16* WCS = (bf16*)(A.ws + WS_WCS);
    for (int i = gt; i < 128 * 64; i += NGT) { const int n = i >> 6, k = i & 63; float sn, cs; sincospif((float)((k * n) & 63) * (1.0f / 32.0f), &sn, &cs); W64[i] = (bf16)f2bf(n < 64 ? cs : -sn); }
    for (int i = gt; i < 256 * 256; i += NGT) { const int n = i >> 8, k = i & 255; const int k2 = n & 127, s2 = k & 127; float sn, cs; sincospif((float)((s2 * k2) & 127) * (1.0f / 64.0f), &sn, &cs);
        float v; if (n < 128) v = (k < 128) ? cs : sn; else v = (k < 128) ? -sn : cs; BT3[i] = (bf16)f2bf(v); }
    for (int i = gt; i < 4 * 128 * 256; i += NGT) { const int g = i >> 15, d = (i >> 8) & 127, k = i & 255, kk = k & 127; float a = 0.f;
        for (int c = 0; c < 128; ++c) { float sn, cs; sincospif((float)((kk * c) & 127) * (1.0f / 64.0f), &sn, &cs); a += ((k < 128) ? cs : sn) * w_four[(size_t)(g * 128 + c) * 128 + d]; }
        WCS[i] = (bf16)f2bf(a * (1.0f / 1024.0f)); }
}

__device__ __forceinline__ float alibi_slope(int h) { return h < 8 ? exp2f(-(float)(h + 1)) : exp2f(-(0.5f + (float)(h - 8))); }
__device__ __forceinline__ void attn_phase(const Args& A, unsigned char* lds) {
    const int tid = threadIdx.x, lane = tid & 63, wid = tid >> 6, fr = lane & 15, g = lane >> 4;
    constexpr int RS = 272; constexpr float LOG2E = 1.4426950408889634f;
    unsigned char* Ks = lds; unsigned char* Vs = lds + 128 * RS;
    const bf16* Q = (const bf16*)(A.ws + WS_Q); const bf16* Kb = (const bf16*)(A.ws + WS_K); const bf16* VT = (const bf16*)(A.ws + WS_VT);
    bf16* MIX = (bf16*)(A.ws + WS_MIX); float* SSQA = (float*)(A.ws + WS_SSQA); const float* sink = A.in[3];
    for (int unit = blockIdx.x; unit < 768; unit += gridDim.x) {
        const int hq = unit % 12, nb = unit / 12, kvh = hq / 3;
        const int c_lo = nb > 0 ? nb - 1 : 0, c_hi = nb < 63 ? nb + 1 : 63;
        const int tq = 128 * nb + 16 * wid + fr;
        f32x4 o[8]; float mrun = sink[hq] * LOG2E, lrun = 1.f; const float slope2 = alibi_slope(hq) * LOG2E;
#pragma unroll
        for (int dt = 0; dt < 8; ++dt) o[dt] = (f32x4){0.f, 0.f, 0.f, 0.f};
        bf16x8 qf[4];
#pragma unroll
        for (int kk = 0; kk < 4; ++kk) qf[kk] = *(const bf16x8*)(Q + (size_t)tq * NQ + hq * 128 + 32 * kk + 8 * g);
        u32x4 pre[8];
        auto gload = [&](int c) {
#pragma unroll
            for (int i = 0; i < 4; ++i) { const int p = tid + 512 * i, row = p >> 4, c16 = p & 15;
                pre[i] = *(const u32x4*)(Kb + (size_t)(128 * c + row) * NKV + kvh * 128 + c16 * 8);
                pre[4 + i] = *(const u32x4*)(VT + (size_t)(kvh * 128 + row) * SEQ + 128 * c + c16 * 8); } };
        auto lstore = [&]() {
#pragma unroll
            for (int i = 0; i < 4; ++i) { const int p = tid + 512 * i, row = p >> 4, c16 = p & 15;
                *(u32x4*)(Ks + row * RS + c16 * 16) = pre[i]; *(u32x4*)(Vs + row * RS + c16 * 16) = pre[4 + i]; } };
        gload(c_lo); __syncthreads(); lstore(); __syncthreads();
        for (int c = c_lo; c <= c_hi; ++c) {
            if (c < c_hi) gload(c + 1);
            f32x4 s[8];
#pragma unroll
            for (int kt = 0; kt < 8; ++kt) { s[kt] = (f32x4){0.f, 0.f, 0.f, 0.f};
#pragma unroll
                for (int kk = 0; kk < 4; ++kk) { const bf16x8 a = *(const bf16x8*)(Ks + (16 * kt + fr) * RS + (32 * kk + 8 * g) * 2); s[kt] = MFMA16(a, qf[kk], s[kt]); } }
            float mx = -3.0e38f;
#pragma unroll
            for (int kt = 0; kt < 8; ++kt)
#pragma unroll
                for (int r = 0; r < 4; ++r) { const int rel = 128 * c + 16 * kt + 4 * g + r - tq; const int ar = rel < 0 ? -rel : rel;
                    float v = s[kt][r] - slope2 * (float)ar; if (ar > 128) v = -1.0e30f; s[kt][r] = v; mx = fmaxf(mx, v); }
            mx = fmaxf(mx, __shfl_xor(mx, 16)); mx = fmaxf(mx, __shfl_xor(mx, 32));
            const float mnew = fmaxf(mrun, mx); const float alpha = __builtin_amdgcn_exp2f(mrun - mnew); mrun = mnew;
            float sum = 0.f;
#pragma unroll
            for (int kt = 0; kt < 8; ++kt)
#pragma unroll
                for (int r = 0; r < 4; ++r) { const float p = __builtin_amdgcn_exp2f(s[kt][r] - mnew); s[kt][r] = p; sum += p; }
            sum += __shfl_xor(sum, 16); sum += __shfl_xor(sum, 32);
            lrun = lrun * alpha + sum;
#pragma unroll
            for (int dt = 0; dt < 8; ++dt) o[dt] *= alpha;
            bf16x8 pb[4];
#pragma unroll
            for (int ks = 0; ks < 4; ++ks) { u32x4 w; w.x = pk2(s[2 * ks][0], s[2 * ks][1]); w.y = pk2(s[2 * ks][2], s[2 * ks][3]); w.z = pk2(s[2 * ks + 1][0], s[2 * ks + 1][1]); w.w = pk2(s[2 * ks + 1][2], s[2 * ks + 1][3]); pb[ks] = __builtin_bit_cast(bf16x8, w); }
#pragma unroll
            for (int dt = 0; dt < 8; ++dt)
#pragma unroll
                for (int ks = 0; ks < 4; ++ks) { const bf16x8 a = *(const bf16x8*)(Vs + (16 * dt + fr) * RS + (32 * ks + 8 * g) * 2); o[dt] = MFMA16(a, pb[ks], o[dt]); }
            __syncthreads();
            if (c < c_hi) { lstore(); __syncthreads(); }
        }
        const float inv = 1.0f / lrun; float sq = 0.f;
#pragma unroll
        for (int dt = 0; dt < 8; ++dt) { const f32x4 v = o[dt] * inv; sq += (v[0] * v[0] + v[1] * v[1]) + (v[2] * v[2] + v[3] * v[3]);
            u32x2 w; w.x = pk2(v[0], v[1]); w.y = pk2(v[2], v[3]); *(u32x2*)(MIX + (size_t)tq * DM + hq * 128 + 16 * dt + 4 * g) = w; }
        sq += __shfl_xor(sq, 16); sq += __shfl_xor(sq, 32);
        if (g == 0) SSQA[(size_t)tq * 12 + hq] = sq;
    }
}
__device__ __forceinline__ void f1_phase(const Args& A) {
    const int tid = threadIdx.x, lane = tid & 63, wid = tid >> 6, fr = lane & 15, g = lane >> 4;
    const bf16* UP = (const bf16*)(A.ws + WS_UP); const bf16* W64 = (const bf16*)(A.ws + WS_W64); bf16* YB = (bf16*)(A.ws + WS_YB);
    const int gw = blockIdx.x * NWAVES + wid, NGW = gridDim.x * NWAVES;
    bf16x8 bfr[8][2];
#pragma unroll
    for (int nt = 0; nt < 8; ++nt)
#pragma unroll
        for (int kk = 0; kk < 2; ++kk) bfr[nt][kk] = *(const bf16x8*)(W64 + (16 * nt + fr) * 64 + 32 * kk + 8 * g);
    for (int rt = gw; rt < 4096; rt += NGW) {
        const int R0 = rt * 16, ch = R0 >> 7, s20 = R0 & 127;
        bf16x8 a[2];
#pragma unroll
        for (int kk = 0; kk < 2; ++kk) a[kk] = *(const bf16x8*)(UP + (size_t)(R0 + fr) * 64 + 32 * kk + 8 * g);
        f32x4 d[8];
#pragma unroll
        for (int nt = 0; nt < 8; ++nt) { d[nt] = (f32x4){0.f, 0.f, 0.f, 0.f};
#pragma unroll
            for (int kk = 0; kk < 2; ++kk) d[nt] = MFMA16(a[kk], bfr[nt][kk], d[nt]); }
#pragma unroll
        for (int nt = 0; nt < 4; ++nt) { const int k1 = 16 * nt + fr; float pr[4], pi[4];
#pragma unroll
            for (int r = 0; r < 4; ++r) { const int s2 = s20 + 4 * g + r; float sn, cs; sincospif((float)(s2 * k1) * (1.0f / 4096.0f), &sn, &cs);
                const float yr = d[nt][r], yi = d[nt + 4][r]; pr[r] = yr * cs + yi * sn; pi[r] = yi * cs - yr * sn; }
            bf16* dst = YB + (size_t)(ch * 64 + k1) * 256 + s20 + 4 * g;
            u32x2 w; w.x = pk2(pr[0], pr[1]); w.y = pk2(pr[2], pr[3]); *(u32x2*)dst = w;
            w.x = pk2(pi[0], pi[1]); w.y = pk2(pi[2], pi[3]); *(u32x2*)(dst + 128) = w; }
    }
}
__device__ __forceinline__ void f3_phase(const Args& A, unsigned char* lds) {
    const int tid = threadIdx.x, lane = tid & 63, wid = tid >> 6, fr = lane & 15, g = lane >> 4;
    const bf16* YB = (const bf16*)(A.ws + WS_YB); const bf16* BT3 = (const bf16*)(A.ws + WS_BT3); bf16* VB = (bf16*)(A.ws + WS_VB);
    constexpr int RS = 528;
    for (int i = 0; i < 16; ++i) { const int p = tid + 512 * i, row = p >> 5, c16 = p & 31; *(u32x4*)(lds + row * RS + c16 * 16) = *(const u32x4*)(BT3 + row * 256 + c16 * 8); }
    __syncthreads();
    for (int blk = blockIdx.x; blk < 256; blk += gridDim.x) {
        const int rt = blk * 8 + wid, k1 = rt >> 5, ch0 = (rt & 31) * 16;
        const bf16* ap = YB + (size_t)((ch0 + fr) * 64 + k1) * 256 + 8 * g;
        bf16x8 a[8];
#pragma unroll
        for (int kk = 0; kk < 8; ++kk) a[kk] = *(const bf16x8*)(ap + 32 * kk);
        const int grp = ch0 >> 7, cb = (ch0 & 127) + 4 * g;
#pragma unroll 4
        for (int nt = 0; nt < 16; ++nt) { f32x4 d = (f32x4){0.f, 0.f, 0.f, 0.f};
#pragma unroll
            for (int kk = 0; kk < 8; ++kk) { const bf16x8 b = *(const bf16x8*)(lds + (16 * nt + fr) * RS + (32 * kk + 8 * g) * 2); d = MFMA16(a[kk], b, d); }
            const int jc = 16 * nt + fr, k2 = jc & 127, im = jc >> 7, sp = k1 + 64 * k2;
            u32x2 w; w.x = pk2(d[0], d[1]); w.y = pk2(d[2], d[3]); *(u32x2*)(VB + (size_t)sp * 1024 + grp * 256 + im * 128 + cb) = w; }
    }
    __syncthreads();
}
__device__ __forceinline__ void f4_phase(const Args& A, unsigned char* lds) {
    const int tid = threadIdx.x, lane = tid & 63, wid = tid >> 6, fr = lane & 15, g = lane >> 4;
    const bf16* VB = (const bf16*)(A.ws + WS_VB); const bf16* WCS = (const bf16*)(A.ws + WS_WCS); bf16* MIX = (bf16*)(A.ws + WS_MIX);
    const float* SSQA = (const float*)(A.ws + WS_SSQA); float* RSA = (float*)(A.ws + WS_RSA);
    float* P = (float*)lds;
    const int g4 = wid & 3, half = wid >> 2;
    for (int blk = blockIdx.x; blk < 256; blk += gridDim.x) {
        const int sp = blk * 32 + half * 16 + fr;
        bf16x8 b[8];
#pragma unroll
        for (int kk = 0; kk < 8; ++kk) b[kk] = *(const bf16x8*)(VB + (size_t)sp * 1024 + g4 * 256 + 32 * kk + 8 * g);
        f32x4 o[8]; float sq = 0.f;
#pragma unroll
        for (int dt = 0; dt < 8; ++dt) { o[dt] = (f32x4){0.f, 0.f, 0.f, 0.f};
#pragma unroll
            for (int kk = 0; kk < 8; ++kk) { const bf16x8 a = *(const bf16x8*)(WCS + (size_t)(g4 * 128 + 16 * dt + fr) * 256 + 32 * kk + 8 * g); o[dt] = MFMA16(a, b[kk], o[dt]); }
            sq += (o[dt][0] * o[dt][0] + o[dt][1] * o[dt][1]) + (o[dt][2] * o[dt][2] + o[dt][3] * o[dt][3]); }
        sq += __shfl_xor(sq, 16); sq += __shfl_xor(sq, 32);
        if (g == 0) P[(half * 16 + fr) * 4 + g4] = sq;
        __syncthreads();
        const float* pp = P + (half * 16 + fr) * 4; const float tot = (pp[0] + pp[1]) + (pp[2] + pp[3]);
        const float rsf = 1.0f / sqrtf(tot * (1.0f / 512.0f) + RMS_EPS);
        float sa = 0.f;
#pragma unroll
        for (int h = 0; h < 12; ++h) sa += SSQA[(size_t)sp * 12 + h];
        const float rsa = 1.0f / sqrtf(sa * (1.0f / 1536.0f) + RMS_EPS);
        const float sc = rsf / rsa;
#pragma unroll
        for (int dt = 0; dt < 8; ++dt) { u32x2 w; w.x = pk2(o[dt][0] * sc, o[dt][1] * sc); w.y = pk2(o[dt][2] * sc, o[dt][3] * sc); *(u32x2*)(MIX + (size_t)sp * DM + NQ + g4 * 128 + 16 * dt + 4 * g) = w; }
        if (g4 == 0 && g == 0) RSA[sp] = rsa;
        __syncthreads();
    }
}
__device__ __forceinline__ void fixup_phase(const Args& A) {
    const float* edge = (const float*)(A.ws + WS_EDGE); const float* dww = A.in[10]; bf16* ACT = (bf16*)(A.ws + WS_ACT);
    const int gt = blockIdx.x * NTHREADS + threadIdx.x, NGT = gridDim.x * NTHREADS;
    for (int i = gt; i < 64 * (DFF / 4); i += NGT) { const int pe = i / (DFF / 4), c = (i % (DFF / 4)) * 4, pm = pe >> 1, e = pe & 1;
        const float* eb = edge + (size_t)(pe * 3) * DFF + c;
        f32x4 gp = *(const f32x4*)eb; const f32x4 V = *(const f32x4*)(eb + DFF);
        if (e == 0 && pm > 0) { const f32x4 G = *(const f32x4*)(edge + (size_t)(((pm - 1) * 2 + 1) * 3 + 2) * DFF + c); gp += *(const f32x4*)(dww + c) * G; }
        if (e == 1 && pm < 31) { const f32x4 G = *(const f32x4*)(edge + (size_t)(((pm + 1) * 2 + 0) * 3 + 2) * DFF + c); gp += *(const f32x4*)(dww + 2 * DFF + c) * G; }
        const pg8::f32x2 g0 = pg8::gelu_pk((pg8::f32x2){gp[0], gp[1]}), g1 = pg8::gelu_pk((pg8::f32x2){gp[2], gp[3]});
        const int row = 256 * pm + (e ? 255 : 0);
        u32x2 w; w.x = pk2(g0.x * V[0], g0.y * V[1]); w.y = pk2(g1.x * V[2], g1.y * V[3]); *(u32x2*)(ACT + (size_t)row * DFF + c) = w; }
}
__device__ __forceinline__ void final_phase(const Args& A) {
    const int tid = threadIdx.x, lane = tid & 63, wave = tid >> 6; const int gw = blockIdx.x * NWAVES + wave, NGW = gridDim.x * NWAVES;
    const float* SSQ2 = (const float*)(A.ws + WS_SSQ2); const float* ng = A.in[13];
    for (int m = gw; m < SEQ; m += NGW) {
        const f32x4 a = *(const f32x4*)(SSQ2 + (size_t)m * 8), b = *(const f32x4*)(SSQ2 + (size_t)m * 8 + 4);
        const float t = ((a[0] + a[1]) + (a[2] + a[3])) + ((b[0] + b[1]) + (b[2] + b[3])); const float rs = 1.0f / sqrtf(t * (1.0f / DM) + RMS_EPS);
        f32x4* xr = (f32x4*)(A.out + (size_t)m * DM) + lane; const f32x4* gr = (const f32x4*)ng + lane;
#pragma unroll
        for (int j = 0; j < 8; ++j) { const f32x4 v = xr[64 * j]; xr[64 * j] = v * rs * gr[64 * j]; }
    }
}

typedef __attribute__((address_space(1))) unsigned gu32;
#define RLX_AGENT __ATOMIC_RELAXED, __HIP_MEMORY_SCOPE_AGENT
#define XB_TMO      128
#define XB_XCNT(j)  (256  + 64 * (j))
#define XB_XSUB(j)  (1280 + 64 * (j))
#define XB_XGEN(j)  (2304 + 64 * (j))
#define XB_TOP      3328
#define XB_TOPGEN   3392
#define XCD_BAR_WORDS 3456
#define XB_SPIN_CAP (1u << 18)

__device__ __forceinline__ unsigned xb_ld(unsigned* p)              { return __hip_atomic_load(p, __ATOMIC_RELAXED, __HIP_MEMORY_SCOPE_AGENT); }
__device__ __forceinline__ unsigned xb_add(unsigned* p, unsigned v) { return __hip_atomic_fetch_add(p, v, __ATOMIC_RELAXED, __HIP_MEMORY_SCOPE_AGENT); }
__device__ __forceinline__ unsigned xb_xcc_id() { return (unsigned)__builtin_amdgcn_s_getreg((3 << 11) | 20) & 0xFu; }
#define XB_SPIN(cond, bar) do { unsigned _sp = 0; while (cond) { __builtin_amdgcn_s_sleep(1); \
    if ((++_sp & 255u) == 0u) { if (xb_ld(&(bar)[XB_TMO])) break; if (_sp > XB_SPIN_CAP) { atomicAdd(&(bar)[XB_TMO], 1u); break; } } } } while (0)

struct XcdBarrier {
    unsigned* bar; unsigned x;
    volatile LAS unsigned* st;
};

__device__ __forceinline__ XcdBarrier xcd_barrier_post(unsigned* bar, volatile LAS unsigned* st) {
    XcdBarrier b; b.bar = bar; b.x = xb_xcc_id(); b.st = st;
    if (threadIdx.x == 0) (void)xb_add(&bar[XB_XCNT(b.x)], 1u);
    return b;
}
__device__ __forceinline__ void xcd_barrier_complete(unsigned* bar, unsigned x, unsigned& nloc, unsigned& nx) {
    const unsigned G = gridDim.x * gridDim.y * gridDim.z;
    unsigned sum, cnt, mine, sp = 0u;
    for (;;) {
        sum = 0u; cnt = 0u; mine = 0u;
#pragma unroll
        for (unsigned j = 0; j < 16; ++j) { const unsigned c = xb_ld(&bar[XB_XCNT(j)]); sum += c; cnt += (c > 0u) ? 1u : 0u; mine = (j == x) ? c : mine; }
        if (sum == G) break;
        __builtin_amdgcn_s_sleep(1);
        if ((++sp & 255u) == 0u) { if (xb_ld(&bar[XB_TMO])) break; if (sp > XB_SPIN_CAP) { atomicAdd(&bar[XB_TMO], 1u); break; } }
    }
    nloc = mine > 0u ? mine : 1u; nx = cnt > 0u ? cnt : 1u;
}

__device__ __forceinline__ void xcd_barrier(const XcdBarrier& b) {
    asm volatile("s_waitcnt vmcnt(0)" ::: "memory");
    __syncthreads();
    if (threadIdx.x == 0) {
        unsigned* bar = b.bar;
        __builtin_amdgcn_s_waitcnt(0);
        unsigned nloc = b.st[0], nx = b.st[1];
        if (nloc == 0u) { xcd_barrier_complete(bar, b.x, nloc, nx); b.st[0] = nloc; b.st[1] = nx; }
        const unsigned old = xb_add(&bar[XB_XSUB(b.x)], 1u);
        const unsigned gen = old / nloc;
        if (old + 1u == (gen + 1u) * nloc) {
            __builtin_amdgcn_fence(__ATOMIC_RELEASE, "agent");
            asm volatile("s_waitcnt vmcnt(0)" ::: "memory");
            const unsigned og = xb_add(&bar[XB_TOP], 1u);
            const unsigned tg = og / nx;
            if (og + 1u == (tg + 1u) * nx) xb_add(&bar[XB_TOPGEN], 1u);
            else XB_SPIN(xb_ld(&bar[XB_TOPGEN]) == tg, bar);
            __builtin_amdgcn_fence(__ATOMIC_ACQUIRE, "agent");
            xb_add(&bar[XB_XGEN(b.x)], 1u);
            asm volatile("s_waitcnt vmcnt(0)" ::: "memory");
        } else {
            XB_SPIN(xb_ld(&bar[XB_XGEN(b.x)]) == gen, bar);
            __builtin_amdgcn_fence(__ATOMIC_ACQUIRE, "agent");
            asm volatile("s_waitcnt vmcnt(0)" ::: "memory");
        }
    }
    __syncthreads();
}

constexpr int NPHASE = 10;
__global__ void __launch_bounds__(NTHREADS, 2) fwd_mega(Args A) {
    extern __shared__ __attribute__((aligned(16))) unsigned char lds[];
    LAS unsigned char* ldsl = (LAS unsigned char*)lds;
    cg::grid_group grid = cg::this_grid();
    const int lo = A.ph_lo, hi = A.ph_hi;
    volatile LAS unsigned* MISC = (volatile LAS unsigned*)(ldsl + LDS_BYTES - 64);
    if (threadIdx.x < 16) MISC[threadIdx.x] = 0u;
    __syncthreads();
    XcdBarrier bar; bar.bar = (unsigned*)(A.ws + WS_CTL); bar.x = 0; bar.st = nullptr;
    if (hi - lo > 1) bar = xcd_barrier_post((unsigned*)(A.ws + WS_CTL), MISC + 8);
    if (hi > 1000) grid.sync();
#ifndef ONLY
#define ONLY -1
#endif
#define IN(k) ((ONLY < 0 || ONLY == (k)) && lo <= (k) && (k) < hi)
#define SEAM(k) do { if (IN(k) && IN((k) + 1)) xcd_barrier(bar); } while (0)
    unsigned char* ws = A.ws;
    const bf16* XB = (const bf16*)(ws + WS_XB); const float* RS1 = (const float*)(ws + WS_RS1);
    if (IN(0)) { p0_prologue(A, lds); } SEAM(0);
    if (IN(1)) {
        { pg8::Gemm gm{XB, (const bf16*)(ws + WS_WIN), SEQ, 2048, DM, 0}; pg8::StaticOrder S; S.init(SEQ, 2048, gridDim.x, blockIdx.x);
          pg8::EpiQK E{(bf16*)(ws + WS_Q), (bf16*)(ws + WS_K), RS1, 0.08838834764831845f * 1.4426950408889634f};
          pg8::gemm_phase<pg8::EpiQK, pg8::StaticOrder, true, true>(ldsl, gm, S, E); }
        { pg8::Gemm gm{(const bf16*)(ws + WS_WIN) + (size_t)2048 * DM, XB, 512, SEQ, DM, 0}; pg8::StaticOrder S; S.init(512, SEQ, gridDim.x, blockIdx.x);
          pg8::EpiVT E{(bf16*)(ws + WS_VT), RS1};
          pg8::gemm_phase<pg8::EpiVT, pg8::StaticOrder, true, true>(ldsl, gm, S, E); }
        { pg8::Gemm gm{(const bf16*)(ws + WS_WIN) + (size_t)2560 * DM, XB, 512, SEQ, DM, 1}; pg8::StaticOrder S; S.init(512, SEQ, gridDim.x, (int)((blockIdx.x + gridDim.x - 64) % gridDim.x));
          pg8::EpiUP E{(bf16*)(ws + WS_UP), RS1};
          pg8::gemm_phase<pg8::EpiUP, pg8::StaticOrder, true, true>(ldsl, gm, S, E); }
    } SEAM(1);
    if (IN(2)) { attn_phase(A, lds); f1_phase(A); } SEAM(2);
    if (IN(3)) { f3_phase(A, lds); } SEAM(3);
    if (IN(4)) { f4_phase(A, lds); } SEAM(4);
    if (IN(5)) {
        pg8::Gemm gm{(const bf16*)(ws + WS_MIX), (const bf16*)(ws + WS_WOUT), SEQ, DM, DM, 0}; pg8::StaticOrder S; S.init(SEQ, DM, gridDim.x, blockIdx.x);
        pg8::EpiRes E{A.in[0], A.out, (bf16*)(ws + WS_X1B), (const float*)(ws + WS_RSA), (float*)(ws + WS_SSQ1), ldsl + SCR_OFF};
        pg8::gemm_phase<pg8::EpiRes, pg8::StaticOrder, true, true>(ldsl, gm, S, E);
    } SEAM(5);
    if (IN(6)) {
        pg8::Gemm gm{(const bf16*)(ws + WS_X1B), (const bf16*)(ws + WS_WUP), SEQ, NUP, DM, 0}; pg8::StaticOrder S; S.init(SEQ, NUP, gridDim.x, blockIdx.x);
        pg8::EpiUp E{(bf16*)(ws + WS_ACT), (const float*)(ws + WS_SSQ1), A.in[10], A.in[11], (float*)(ws + WS_EDGE), ldsl + SCR_OFF};
        pg8::gemm_phase<pg8::EpiUp, pg8::StaticOrder, true, true>(ldsl, gm, S, E);
    } SEAM(6);
    if (IN(7)) { fixup_phase(A); } SEAM(7);
    if (IN(8)) {
        pg8::Gemm gm{(const bf16*)(ws + WS_ACT), (const bf16*)(ws + WS_WDOWN), SEQ, DM, DFF, 0}; pg8::StaticOrder S; S.init(SEQ, DM, gridDim.x, blockIdx.x);
        pg8::EpiRes E{A.out, A.out, nullptr, nullptr, (float*)(ws + WS_SSQ2), ldsl + SCR_OFF};
        pg8::gemm_phase<pg8::EpiRes, pg8::StaticOrder, true, true>(ldsl, gm, S, E);
    } SEAM(8);
    if (IN(9)) { final_phase(A); }
#undef IN
#undef SEAM
}

#ifndef MK_PER_PHASE
#define MK_PER_PHASE 0
#endif
extern "C" void kernel_launch(void* const* d_in, const int* in_sizes, int n_in, void* d_out, int out_size, void* d_ws, size_t ws_size, hipStream_t stream) {
    static int grid = 0;
    if (grid == 0) {
        if (n_in != 14 || out_size != SEQ * DM || ws_size < WS_END) { fprintf(stderr, "kernel_launch: unexpected shapes (n_in %d out %d ws %zu)\n", n_in, out_size, ws_size); grid = -1; return; }
        int dev = 0, cus = 0, per_cu = 0;
        (void)hipGetDevice(&dev); (void)hipDeviceGetAttribute(&cus, hipDeviceAttributeMultiprocessorCount, dev);
        (void)hipFuncSetAttribute((const void*)fwd_mega, hipFuncAttributeMaxDynamicSharedMemorySize, LDS_BYTES);
        if (hipOccupancyMaxActiveBlocksPerMultiprocessor(&per_cu, (const void*)fwd_mega, NTHREADS, LDS_BYTES) != hipSuccess || per_cu < 1) per_cu = 1;
        (void)hipGetLastError();
        grid = cus * 1;
        if (grid <= 0) grid = 256;
    }
    if (grid < 0) return;
    (void)hipMemsetAsync((unsigned char*)d_ws + WS_CTL, 0, CTL_BYTES, stream);
    Args a{};
    for (int i = 0; i < 14; ++i) a.in[i] = (const float*)d_in[i];
    a.out = (float*)d_out; a.ws = (unsigned char*)d_ws;
#if MK_PER_PHASE
    for (int p = 0; p < NPHASE; ++p) { a.ph_lo = p; a.ph_hi = p + 1; hipLaunchKernelGGL(fwd_mega, dim3(grid), dim3(NTHREADS), LDS_BYTES, stream, a); }
#else
    a.ph_lo = 0; a.ph_hi = NPHASE;
    void* args[] = {&a};
    hipError_t e = hipLaunchCooperativeKernel((const void*)fwd_mega, dim3(grid), dim3(NTHREADS), args, LDS_BYTES, stream);
    if (e != hipSuccess) fprintf(stderr, "cooperative launch failed: %s (grid %d)\n", hipGetErrorString(e), grid);
#endif
}
```

```cpp
#include <hip/hip_runtime.h>
#include <hip/hip_cooperative_groups.h>
#include <cstdio>
#include <cstdint>
namespace cg = cooperative_groups;
namespace pg8 {
#define PG8_LAS __attribute__((address_space(3)))
typedef unsigned short bf16_t;
typedef short bf16x8 __attribute__((ext_vector_type(8)));
typedef float f32x4 __attribute__((ext_vector_type(4)));
typedef unsigned u32x4 __attribute__((ext_vector_type(4)));
constexpr int BM = 256, BK = 64, HALF = 128, HTB = HALF * BK * 2  , STAGE_BYTES = 8 * HTB, NXCD = 8, WGM = 8;

__host__ __device__ __forceinline__ int lds_byte(int r, int c) { const int st = (r >> 4) * 2 + (c >> 5), rr = r & 15, cc = c & 31, ob = rr * 64 + cc * 2; return st * 1024 + (ob ^ (((ob >> 9) & 1) << 5)); }
__host__ __device__ __forceinline__ void stage_rc(int b, int& R, int& C) { const int st = b / 1024, sb = b % 1024, swz = sb ^ (((sb >> 9) & 1) << 5); R = (st >> 1) * 16 + swz / 64; C = (st & 1) * 32 + (swz % 64) / 2; }
__host__ __device__ __forceinline__ int perm32(int rho) { const int n = rho >> 4, i = rho & 15; return 8 * (i >> 2) + 4 * n + (i & 3); }

struct Unit { int pm, pn; };
struct Gemm { const bf16_t* A; const bf16_t* Bt; int M, N, K; int bmode; };

struct StaticOrder {
    int nM, nN, nwg, G, c;
    __host__ __device__ void init(int M, int N, int G_, int c_) { nM = M / BM; nN = N / BM; nwg = nM * nN; G = G_; c = c_; }
    __host__ __device__ bool next(int i, Unit& u) const {
        const long L = (long)i * G + c; if (L >= nwg) return false;
        int wgid = (int)L; { const int q = nwg / NXCD, r = nwg % NXCD, xcd = wgid % NXCD, off = wgid / NXCD; wgid = (xcd < r ? xcd * (q + 1) : r * (q + 1) + (xcd - r) * q) + off; }
        const int nig = WGM * nN, gid = wgid / nig, fm = gid * WGM, gsz = (nM - fm) < WGM ? (nM - fm) : WGM;
        u.pm = fm + ((wgid % nig) % gsz); u.pn = (wgid % nig) / gsz; return true;
    }
    __device__ __forceinline__ void a_ready(const Unit&) const {}
    __device__ __forceinline__ void done(const Unit&) const {}
};

__device__ __forceinline__ unsigned cvt_pk_bf16(float lo, float hi) { unsigned r; asm volatile("v_cvt_pk_bf16_f32 %0, %1, %2" : "=v"(r) : "v"(lo), "v"(hi)); return r; }
typedef float f32x2 __attribute__((ext_vector_type(2)));
typedef unsigned u32x2 __attribute__((ext_vector_type(2)));
__device__ __forceinline__ f32x2 gelu_pk(f32x2 v) {
    const f32x2 av = __builtin_elementwise_abs(v), d = av * 0.2316418882f + 1.0f;
    f32x2 t; t.x = __builtin_amdgcn_rcpf(d.x); t.y = __builtin_amdgcn_rcpf(d.y);
    f32x2 q = t * 0.5307027145f + (-0.7265760135f); q = q * t + 0.7107068705f; q = q * t + (-0.142248368f); q = q * t + 0.127414796f; q = q * t;
    const f32x2 s = (v * v) * (-0.72134752044f);
    f32x2 e; e.x = __builtin_amdgcn_exp2f(s.x); e.y = __builtin_amdgcn_exp2f(s.y);
    const f32x2 m = v * (q * e), r = v - m;
    f32x2 o; o.x = v.x < 0.f ? m.x : r.x; o.y = v.y < 0.f ? m.y : r.y; return o;
}
#define EPI_BAR() do { asm volatile("s_waitcnt lgkmcnt(0)" ::: "memory"); __builtin_amdgcn_s_barrier(); asm volatile("" ::: "memory"); } while (0)
constexpr float RMS_EPS = 1e-6f;

struct EpiQK {
    static constexpr bool PERM = true, AFTER_DRAIN = false;
    bf16_t* Q; bf16_t* Kb; const float* rs1; float qscale;
    __device__ __forceinline__ void operator()(f32x4 (&acc)[2][2][4][2], const Unit& u, int wr, int wc, int fr, int fq) const {
        const int row0 = u.pm * BM + wr * 64 + fr; const int colt = u.pn * BM;
        bf16_t* base; int ldc; float sc;
        if (colt < 1536) { base = Q + colt; ldc = 1536; sc = qscale; } else { base = Kb + (colt - 1536); ldc = 512; sc = 1.f; }
        const int col0 = wc * 32 + 8 * fq;
#pragma unroll
        for (int ai = 0; ai < 2; ++ai)
#pragma unroll
            for (int m = 0; m < 4; ++m) { const int row = row0 + ai * HALF + m * 16; const float s = rs1[row] * sc; bf16_t* rowp = base + (size_t)row * ldc + col0;
#pragma unroll
                for (int bj = 0; bj < 2; ++bj) { const f32x4 v0 = acc[ai][bj][m][0] * s, v1 = acc[ai][bj][m][1] * s;
                    u32x4 w; w.x = cvt_pk_bf16(v0[0], v0[1]); w.y = cvt_pk_bf16(v0[2], v0[3]); w.z = cvt_pk_bf16(v1[0], v1[1]); w.w = cvt_pk_bf16(v1[2], v1[3]);
                    *(u32x4*)(rowp + bj * HALF) = w; } }
    }
};
struct EpiVT {
    static constexpr bool PERM = false, AFTER_DRAIN = false;
    bf16_t* O; const float* rs1;
    __device__ __forceinline__ void operator()(f32x4 (&acc)[2][2][4][2], const Unit& u, int wr, int wc, int fr, int fq) const {
        const int row0 = u.pm * BM + wr * 64 + fr;
#pragma unroll
        for (int bj = 0; bj < 2; ++bj) {
            const int tok0 = u.pn * BM + bj * HALF + wc * 32 + 4 * fq;
            const f32x4 s0 = *(const f32x4*)(rs1 + tok0), s1 = *(const f32x4*)(rs1 + tok0 + 16);
            const int pos0 = u.pn * BM + bj * HALF + wc * 32 + 8 * fq;
#pragma unroll
            for (int ai = 0; ai < 2; ++ai)
#pragma unroll
                for (int m = 0; m < 4; ++m) { const int row = row0 + ai * HALF + m * 16; const f32x4 v0 = acc[ai][bj][m][0] * s0, v1 = acc[ai][bj][m][1] * s1;
                    u32x4 w; w.x = cvt_pk_bf16(v0[0], v0[1]); w.y = cvt_pk_bf16(v0[2], v0[3]); w.z = cvt_pk_bf16(v1[0], v1[1]); w.w = cvt_pk_bf16(v1[2], v1[3]);
                    *(u32x4*)(O + (size_t)row * 8192 + pos0) = w; }
        }
    }
};
struct EpiUP {
    static constexpr bool PERM = true, AFTER_DRAIN = false;
    bf16_t* O; const float* rs1;
    __device__ __forceinline__ void operator()(f32x4 (&acc)[2][2][4][2], const Unit& u, int wr, int wc, int fr, int fq) const {
        const int row0 = u.pm * BM + wr * 64 + fr;
#pragma unroll
        for (int bj = 0; bj < 2; ++bj) {
            const int s2 = 4 * u.pn + 2 * bj + (wc >> 1); const int s1b = 32 * (wc & 1) + 8 * fq;
            float sc[8];
#pragma unroll
            for (int e = 0; e < 8; ++e) sc[e] = rs1[128 * (s1b + e) + s2];
            const int pos0 = u.pn * BM + bj * HALF + wc * 32 + 8 * fq;
#pragma unroll
            for (int ai = 0; ai < 2; ++ai)
#pragma unroll
                for (int m = 0; m < 4; ++m) { const int row = row0 + ai * HALF + m * 16; const f32x4 v0 = acc[ai][bj][m][0], v1 = acc[ai][bj][m][1];
                    u32x4 w; w.x = cvt_pk_bf16(v0[0] * sc[0], v0[1] * sc[1]); w.y = cvt_pk_bf16(v0[2] * sc[2], v0[3] * sc[3]); w.z = cvt_pk_bf16(v1[0] * sc[4], v1[1] * sc[5]); w.w = cvt_pk_bf16(v1[2] * sc[6], v1[3] * sc[7]);
                    *(u32x4*)(O + (size_t)row * 8192 + pos0) = w; }
        }
    }
};
struct EpiRes {
    static constexpr bool PERM = false, AFTER_DRAIN = false;
    const float* base; float* out; bf16_t* outb; const float* rowscale; float* ssq; PG8_LAS unsigned char* scr;
    __device__ __forceinline__ void operator()(f32x4 (&acc)[2][2][4][2], const Unit& u, int wr, int wc, int fr, int fq) const {
        const int col0 = u.pn * BM + wc * 32 + 4 * fq;
        PG8_LAS float* P = (PG8_LAS float*)scr;
#pragma unroll
        for (int ai = 0; ai < 2; ++ai)
#pragma unroll
            for (int m = 0; m < 4; ++m) { const int r = ai * HALF + wr * 64 + m * 16 + fr; const int row = u.pm * BM + r; const float sc = rowscale ? rowscale[row] : 1.f; float s = 0.f;
#pragma unroll
                for (int bj = 0; bj < 2; ++bj)
#pragma unroll
                    for (int n = 0; n < 2; ++n) { const size_t off = (size_t)row * 2048 + col0 + bj * HALF + n * 16; const f32x4 b = *(const f32x4*)(base + off); const f32x4 o = b + acc[ai][bj][m][n] * sc;
                        *(f32x4*)(out + off) = o; s += (o[0] * o[0] + o[1] * o[1]) + (o[2] * o[2] + o[3] * o[3]);
                        if (outb) { u32x2 w; w.x = cvt_pk_bf16(o[0], o[1]); w.y = cvt_pk_bf16(o[2], o[3]); *(u32x2*)(outb + off) = w; } }
                s += __shfl_xor(s, 16); s += __shfl_xor(s, 32);
                if (fq == 0) P[r * 4 + wc] = s; }
        EPI_BAR();
        const int tid = threadIdx.x;
        if (tid < 256) { const f32x4 p = *(const PG8_LAS f32x4*)(P + tid * 4); ssq[(size_t)(u.pm * BM + tid) * 8 + u.pn] = (p[0] + p[1]) + (p[2] + p[3]); }
    }
};
struct EpiUp {
    static constexpr bool PERM = false, AFTER_DRAIN = false;
    bf16_t* act; const float* ssq1; const float* dww; const float* dwb; float* edge; PG8_LAS unsigned char* scr;
    __device__ __forceinline__ void operator()(f32x4 (&acc)[2][2][4][2], const Unit& u, int wr, int wc, int fr, int fq) const {
        const int lane = threadIdx.x & 63;
#pragma unroll
        for (int ai = 0; ai < 2; ++ai)
#pragma unroll
            for (int m = 0; m < 4; ++m) { const int row = u.pm * BM + ai * HALF + wr * 64 + m * 16 + fr; const f32x4 a = *(const f32x4*)(ssq1 + (size_t)row * 8), b = *(const f32x4*)(ssq1 + (size_t)row * 8 + 4);
                const float t = ((a[0] + a[1]) + (a[2] + a[3])) + ((b[0] + b[1]) + (b[2] + b[3])); const float rs = 1.0f / sqrtf(t * (1.0f / 2048.0f) + RMS_EPS);
#pragma unroll
                for (int bj = 0; bj < 2; ++bj)
#pragma unroll
                    for (int n = 0; n < 2; ++n) acc[ai][bj][m][n] *= rs; }
        PG8_LAS float* halo = (PG8_LAS float*)scr;
        const int cl = 32 * wc + 4 * fq;
#pragma unroll
        for (int ai = 0; ai < 2; ++ai) { const int seg = 2 * ai + wr;
            if (fr == 0) {
#pragma unroll
                for (int n = 0; n < 2; ++n) *(PG8_LAS f32x4*)(halo + (seg * 2 + 0) * 128 + cl + 16 * n) = acc[ai][0][0][n]; }
            if (fr == 15) {
#pragma unroll
                for (int n = 0; n < 2; ++n) *(PG8_LAS f32x4*)(halo + (seg * 2 + 1) * 128 + cl + 16 * n) = acc[ai][0][3][n]; } }
        EPI_BAR();
        const int c0 = 128 * u.pn + cl;
        const int src_up = (lane & 48) | ((fr + 15) & 15), src_dn = (lane & 48) | ((fr + 1) & 15);
#pragma unroll
        for (int n = 0; n < 2; ++n) {
            const f32x4 w0 = *(const f32x4*)(dww + c0 + 16 * n), w1 = *(const f32x4*)(dww + 5504 + c0 + 16 * n), w2 = *(const f32x4*)(dww + 11008 + c0 + 16 * n), bb = *(const f32x4*)(dwb + c0 + 16 * n);
#pragma unroll
            for (int ai = 0; ai < 2; ++ai) { const int seg = 2 * ai + wr;
                f32x4 hu = (f32x4){0.f, 0.f, 0.f, 0.f}, hd = (f32x4){0.f, 0.f, 0.f, 0.f};
                if (seg > 0) hu = *(const PG8_LAS f32x4*)(halo + ((seg - 1) * 2 + 1) * 128 + cl + 16 * n);
                if (seg < 3) hd = *(const PG8_LAS f32x4*)(halo + ((seg + 1) * 2 + 0) * 128 + cl + 16 * n);
#pragma unroll
                for (int m = 0; m < 4; ++m) {
                    const f32x4 G = acc[ai][0][m][n];
                    f32x4 xu = G, xd = G;
                    if (m > 0 && fr == 15) xu = acc[ai][0][m - 1][n];
                    if (m < 3 && fr == 0) xd = acc[ai][0][m + 1][n];
                    f32x4 U, D;
#pragma unroll
                    for (int e = 0; e < 4; ++e) { U[e] = __shfl(xu[e], src_up); D[e] = __shfl(xd[e], src_dn); }
                    if (m == 0 && fr == 0) U = hu;
                    if (m == 3 && fr == 15) D = hd;
                    const f32x4 gp = w0 * U + w1 * G + w2 * D + bb;
                    const f32x4 V = acc[ai][1][m][n];
                    const f32x2 g0 = gelu_pk((f32x2){gp[0], gp[1]}), g1 = gelu_pk((f32x2){gp[2], gp[3]});
                    const int row = u.pm * BM + ai * HALF + wr * 64 + m * 16 + fr;
                    u32x2 w; w.x = cvt_pk_bf16(g0.x * V[0], g0.y * V[1]); w.y = cvt_pk_bf16(g1.x * V[2], g1.y * V[3]);
                    *(u32x2*)(act + (size_t)row * 5504 + c0 + 16 * n) = w;
                    if (ai == 0 && m == 0 && wr == 0 && fr == 0) { float* e0 = edge + (size_t)((u.pm * 2 + 0) * 3) * 5504 + c0 + 16 * n;
                        *(f32x4*)(e0) = gp; *(f32x4*)(e0 + 5504) = V; *(f32x4*)(e0 + 2 * 5504) = G; }
                    if (ai == 1 && m == 3 && wr == 1 && fr == 15) { float* e1 = edge + (size_t)((u.pm * 2 + 1) * 3) * 5504 + c0 + 16 * n;
                        *(f32x4*)(e1) = gp; *(f32x4*)(e1 + 5504) = V; *(f32x4*)(e1 + 2 * 5504) = G; }
                }
            }
        }
    }
};
template <class Epi, class Sched, bool ALIGN_EPI = false, bool SP2 = false>
__device__ __forceinline__ void gemm_phase(PG8_LAS unsigned char* lds, const Gemm g, const Sched& S, const Epi& E) {
    const int tid = threadIdx.x, wid = __builtin_amdgcn_readfirstlane(tid >> 6), lane = tid & 63, wr = wid >> 2, wc = wid & 3, fr = lane & 15, fq = lane >> 4;
    const int K = g.K, nt = K / BK;
    unsigned voffA[2], voffB[2];
#pragma unroll
    for (int i = 0; i < 2; ++i) { int R, C; stage_rc(tid * 16 + i * 8192, R, C); const int Rb = Epi::PERM ? ((R & ~31) + perm32(R & 31)) : R;
        voffA[i] = (unsigned)(R * K + C) * 2u; voffB[i] = g.bmode ? (unsigned)(((Rb & 63) * 128 + (Rb >> 6)) * K + C) * 2u : (unsigned)(Rb * K + C) * 2u; }
    const size_t kstep = (size_t)(BK * 2);
    const size_t hstepA = (size_t)HALF * K * 2; const size_t hstepB = g.bmode ? (size_t)2 * K * 2 : hstepA;
    const size_t tstepA = 2 * hstepA; const size_t tstepB = 2 * hstepB;
    const unsigned ldsw = (unsigned)wid * 1024u;
    const int aoff = lds_byte(wr * 64 + fr, fq * 8), boff = lds_byte(wc * 32 + fr, fq * 8);
#define PG8_SA(b, h) (((b) * 2 + (h)) * HTB)
#define PG8_SB(b, h) ((4 + (b) * 2 + (h)) * HTB)
#define PG8_STAGE(bufoff, gbase, voff) do { _Pragma("unroll") for (int _i = 0; _i < 2; ++_i) \
        __builtin_amdgcn_global_load_lds((const unsigned*)((const char*)(gbase) + (voff)[_i]), (PG8_LAS unsigned*)(lds + (bufoff) + ldsw + _i * 8192), 16, 0, 0); } while (0)
#define PG8_LDA(dst, b, h) do { _Pragma("unroll") for (int m = 0; m < 4; ++m) _Pragma("unroll") for (int k = 0; k < 2; ++k) dst[m][k] = *(const PG8_LAS bf16x8*)(lds + PG8_SA(b, h) + aoff + m * 2048 + k * 1024); } while (0)
#define PG8_LDB(dst, b, h) do { _Pragma("unroll") for (int n = 0; n < 2; ++n) _Pragma("unroll") for (int k = 0; k < 2; ++k) dst[n][k] = *(const PG8_LAS bf16x8*)(lds + PG8_SB(b, h) + boff + n * 2048 + k * 1024); } while (0)
#define PG8_MMA(ai, bj, At, Bt) do { __builtin_amdgcn_s_setprio(1); _Pragma("unroll") for (int m = 0; m < 4; ++m) _Pragma("unroll") for (int n = 0; n < 2; ++n) _Pragma("unroll") for (int k = 0; k < 2; ++k) \
        acc[ai][bj][m][n] = __builtin_amdgcn_mfma_f32_16x16x32_bf16(Bt[n][k], At[m][k], acc[ai][bj][m][n], 0, 0, 0); __builtin_amdgcn_s_setprio(0); } while (0)
#define PG8_WAIT_V(n) asm volatile("s_waitcnt vmcnt(" #n ")" ::: "memory")
#define PG8_WAIT_L(n) asm volatile("s_waitcnt lgkmcnt(" #n ")" ::: "memory")
#define PG8_BAR __builtin_amdgcn_s_barrier()
#define PG8_SCHED __builtin_amdgcn_sched_barrier(0)
    Unit cur, nxt; int ui = 0;
    if (!S.next(0, cur)) return;
    f32x4 acc[2][2][4][2];
#pragma unroll
    for (int a = 0; a < 2; ++a)
#pragma unroll
        for (int b = 0; b < 2; ++b)
#pragma unroll
            for (int m = 0; m < 4; ++m)
#pragma unroll
                for (int n = 0; n < 2; ++n) acc[a][b][m][n] = (f32x4){0.f, 0.f, 0.f, 0.f};
    bf16x8 At[4][2], B0[2][2], B1[2][2];
    const char* cA = (const char*)g.A + (size_t)cur.pm * tstepA; const char* cB = (const char*)g.Bt + (size_t)cur.pn * tstepB;
    S.a_ready(cur);
    if constexpr (SP2) {
        PG8_STAGE(PG8_SB(0, 0), cB, voffB); PG8_STAGE(PG8_SB(0, 1), cB + hstepB, voffB); PG8_STAGE(PG8_SA(0, 0), cA, voffA); PG8_STAGE(PG8_SA(0, 1), cA + hstepA, voffA);
        if (wr == 1) PG8_BAR;
        PG8_WAIT_V(2); PG8_BAR;
        PG8_STAGE(PG8_SB(1, 0), cB + kstep, voffB); PG8_STAGE(PG8_SA(1, 0), cA + kstep, voffA); PG8_STAGE(PG8_SB(1, 1), cB + hstepB + kstep, voffB);
        PG8_WAIT_V(6); PG8_BAR;
    } else {
        PG8_STAGE(PG8_SB(0, 0), cB, voffB); PG8_STAGE(PG8_SA(0, 0), cA, voffA); PG8_STAGE(PG8_SB(0, 1), cB + hstepB, voffB); PG8_STAGE(PG8_SA(0, 1), cA + hstepA, voffA);
        if (wr == 1) PG8_BAR;
        PG8_WAIT_V(4); PG8_BAR;
        PG8_STAGE(PG8_SB(1, 0), cB + kstep, voffB); PG8_STAGE(PG8_SA(1, 0), cA + kstep, voffA); PG8_STAGE(PG8_SB(1, 1), cB + hstepB + kstep, voffB);
        PG8_WAIT_V(6); PG8_BAR;
    }
    for (;;) {
        const bool has_next = S.next(ui + 1, nxt);
        const char* nA = has_next ? (const char*)g.A + (size_t)nxt.pm * tstepA : cA; const char* nB = has_next ? (const char*)g.Bt + (size_t)nxt.pn * tstepB : cB;
        for (int t = 0; t < nt; t += 2) {
            const bool last = (t == nt - 2);
            const char* a1 = cA + (size_t)(t + 1) * kstep;
            const char* a2 = last ? nA : cA + (size_t)(t + 2) * kstep; const char* b2 = last ? nB : cB + (size_t)(t + 2) * kstep;
            const char* a3 = a2 + kstep; const char* b3 = b2 + kstep;
            if (last && has_next) S.a_ready(nxt);
            if constexpr (SP2) {
            PG8_LDB(B0, 0, 0); PG8_LDB(B1, 0, 1); PG8_SCHED; PG8_LDA(At, 0, 0); PG8_STAGE(PG8_SA(1, 1), a1 + hstepA, voffA);
            PG8_WAIT_V(8); PG8_WAIT_L(0); PG8_BAR; PG8_MMA(0, 0, At, B0); PG8_MMA(0, 1, At, B1); PG8_BAR; PG8_SCHED;
            PG8_LDA(At, 0, 1); PG8_STAGE(PG8_SB(0, 0), b2, voffB); PG8_STAGE(PG8_SB(0, 1), b2 + hstepB, voffB); PG8_STAGE(PG8_SA(0, 0), a2, voffA);
            PG8_WAIT_V(8); PG8_WAIT_L(0); PG8_BAR; PG8_MMA(1, 0, At, B0); PG8_MMA(1, 1, At, B1); PG8_BAR; PG8_SCHED;
            PG8_LDB(B0, 1, 0); PG8_LDB(B1, 1, 1); PG8_SCHED; PG8_LDA(At, 1, 0); PG8_STAGE(PG8_SA(0, 1), a2 + hstepA, voffA);
            PG8_WAIT_V(8); PG8_WAIT_L(0); PG8_BAR; PG8_MMA(0, 0, At, B0); PG8_MMA(0, 1, At, B1); PG8_BAR; PG8_SCHED;
            PG8_LDA(At, 1, 1); PG8_STAGE(PG8_SB(1, 0), b3, voffB); PG8_STAGE(PG8_SB(1, 1), b3 + hstepB, voffB); PG8_STAGE(PG8_SA(1, 0), a3, voffA);
            PG8_WAIT_V(8); PG8_WAIT_L(0); PG8_BAR; PG8_MMA(1, 0, At, B0); PG8_MMA(1, 1, At, B1); PG8_BAR; PG8_SCHED;
            } else {
            PG8_LDB(B0, 0, 0); PG8_SCHED; PG8_LDA(At, 0, 0); PG8_STAGE(PG8_SA(1, 1), a1 + hstepA, voffA);
            PG8_WAIT_L(8); PG8_BAR; PG8_WAIT_L(0); PG8_MMA(0, 0, At, B0); PG8_BAR; PG8_SCHED;
            PG8_LDB(B1, 0, 1); PG8_STAGE(PG8_SB(0, 0), b2, voffB);
            PG8_BAR; PG8_WAIT_L(0); PG8_MMA(0, 1, At, B1); PG8_BAR;
            PG8_LDA(At, 0, 1); PG8_STAGE(PG8_SA(0, 0), a2, voffA);
            PG8_BAR; PG8_WAIT_L(0); PG8_MMA(1, 0, At, B0); PG8_BAR; PG8_SCHED;
            PG8_STAGE(PG8_SB(0, 1), b2 + hstepB, voffB);
            PG8_WAIT_V(6); PG8_BAR; PG8_MMA(1, 1, At, B1); PG8_BAR;
            PG8_LDB(B0, 1, 0); PG8_SCHED; PG8_LDA(At, 1, 0); PG8_STAGE(PG8_SA(0, 1), a2 + hstepA, voffA);
            PG8_WAIT_L(8); PG8_BAR; PG8_WAIT_L(0); PG8_MMA(0, 0, At, B0); PG8_BAR; PG8_SCHED;
            PG8_LDB(B1, 1, 1); PG8_STAGE(PG8_SB(1, 0), b3, voffB);
            PG8_BAR; PG8_WAIT_L(0); PG8_MMA(0, 1, At, B1); PG8_BAR;
            PG8_LDA(At, 1, 1); PG8_STAGE(PG8_SA(1, 0), a3, voffA);
            PG8_BAR; PG8_WAIT_L(0); PG8_MMA(1, 0, At, B0); PG8_BAR; PG8_SCHED;
            PG8_STAGE(PG8_SB(1, 1), b3 + hstepB, voffB);
            PG8_WAIT_V(6); PG8_BAR; PG8_MMA(1, 1, At, B1); PG8_BAR;
            }
        }
        if constexpr (ALIGN_EPI) { if (wr == 0) PG8_BAR; }
        if constexpr (!Epi::AFTER_DRAIN) { E(acc, cur, wr, wc, fr, fq); S.done(cur); }
        if (!has_next) break;
#pragma unroll
        for (int a = 0; a < 2; ++a)
#pragma unroll
            for (int b = 0; b < 2; ++b)
#pragma unroll
                for (int m = 0; m < 4; ++m)
#pragma unroll
                    for (int n = 0; n < 2; ++n) acc[a][b][m][n] = (f32x4){0.f, 0.f, 0.f, 0.f};
        cur = nxt; cA = nA; cB = nB; ++ui;
        if constexpr (ALIGN_EPI) { if (wr == 1) PG8_BAR; }
    }
    PG8_WAIT_V(0);
    if constexpr (!ALIGN_EPI) { if (wr == 0) PG8_BAR; }
    PG8_BAR;
    if constexpr (Epi::AFTER_DRAIN) { E.fused(acc, cur, wr, wc, fr, fq, lds, wid, lane); S.done(cur); }
#undef PG8_SA
#undef PG8_SB
#undef PG8_STAGE
#undef PG8_LDA
#undef PG8_LDB
#undef PG8_MMA
#undef PG8_WAIT_V
#undef PG8_WAIT_L
#undef PG8_BAR
#undef PG8_SCHED
}
}
constexpr int SEQ = 8192, DM = 2048, NQ = 1536, NKV = 512, NFO = 512, NIN = 3072, DFF = 5504, NUP = 11008;
using pg8::RMS_EPS;
constexpr size_t MiB = 1u << 20;
constexpr size_t WS_WIN = 0, WS_WOUT = 12 * MiB, WS_WUP = 20 * MiB, WS_WDOWN = 63 * MiB;
constexpr size_t WS_XB = 85 * MiB, WS_Q = 117 * MiB, WS_K = 141 * MiB, WS_VT = 149 * MiB, WS_UP = 157 * MiB, WS_MIX = 165 * MiB, WS_YB = 197 * MiB, WS_VB = 213 * MiB;
constexpr size_t WS_ACT = 85 * MiB;
constexpr size_t WS_SMALL = 229 * MiB;
constexpr size_t WS_RS1 = WS_SMALL, WS_RSA = WS_SMALL + 32768, WS_SSQA = WS_SMALL + 65536, WS_SSQ1 = WS_SMALL + 524288, WS_SSQ2 = WS_SMALL + 786432;
constexpr size_t WS_W64 = WS_SMALL + 1048576, WS_BT3 = WS_SMALL + 1114112, WS_WCS = WS_SMALL + 1310720, WS_EDGE = WS_SMALL + 2 * MiB;
constexpr size_t WS_CTL = WS_SMALL + 8 * MiB, CTL_BYTES = 16384;
constexpr size_t WS_X1B = 240 * MiB, WS_END = 272 * MiB;
static_assert(WS_ACT + (size_t)SEQ * DFF * 2 <= WS_YB + 16 * MiB && WS_EDGE + (size_t)64 * 3 * DFF * 4 <= WS_X1B, "ws map");
constexpr int RING_BYTES = 131072, SCR_OFF = RING_BYTES + 512, LDS_BYTES = 147456;
constexpr int NWAVES = 8, NTHREADS = 512;
#define LAS __attribute__((address_space(3)))
typedef unsigned short bf16;
typedef float f32x4 __attribute__((ext_vector_type(4)));
typedef short bf16x8 __attribute__((ext_vector_type(8)));
typedef unsigned u32x4 __attribute__((ext_vector_type(4)));
typedef unsigned u32x2 __attribute__((ext_vector_type(2)));
__device__ __forceinline__ unsigned f2bf(float f) { unsigned u = __builtin_bit_cast(unsigned, f); return (u + 0x7fffu + ((u >> 16) & 1u)) >> 16; }
__device__ __forceinline__ unsigned pk2(float lo, float hi) { return f2bf(lo) | (f2bf(hi) << 16); }
__device__ __forceinline__ float wave_sum(float v) {
#pragma unroll
    for (int o = 1; o < 64; o <<= 1) v += __shfl_xor(v, o);
    return v;
}
#define MFMA16(a, b, c) __builtin_amdgcn_mfma_f32_16x16x32_bf16((a), (b), (c), 0, 0, 0)

struct Args { const float* in[14]; float* out; unsigned char* ws; int ph_lo, ph_hi; };

__device__ __forceinline__ void p0_item(const float* W, int K, int N, bf16* WT, int out_row0, const float* ksc, float* scr, int k0, int n0, int lane) {
    const int kr = lane >> 4, nc = (lane & 15) * 4;
    f32x4 v[16];
#pragma unroll
    for (int i = 0; i < 16; ++i) v[i] = *(const f32x4*)(W + (size_t)(k0 + 4 * i + kr) * N + n0 + nc);
#pragma unroll
    for (int i = 0; i < 16; ++i) { const float sc = ksc ? ksc[k0 + 4 * i + kr] : 1.f; float* d = scr + (4 * i + kr) * 65 + nc; d[0] = v[i][0] * sc; d[1] = v[i][1] * sc; d[2] = v[i][2] * sc; d[3] = v[i][3] * sc; }
    asm volatile("s_waitcnt lgkmcnt(0)" ::: "memory");
    const int c = lane & 7;
#pragma unroll
    for (int j = 0; j < 8; ++j) { const int n = (lane >> 3) + 8 * j; const float* s = scr + (8 * c) * 65 + n;
        u32x4 o; o.x = pk2(s[0 * 65], s[1 * 65]); o.y = pk2(s[2 * 65], s[3 * 65]); o.z = pk2(s[4 * 65], s[5 * 65]); o.w = pk2(s[6 * 65], s[7 * 65]);
        *(u32x4*)(WT + (size_t)(out_row0 + n) * K + k0 + 8 * c) = o; }
    asm volatile("s_waitcnt lgkmcnt(0)" ::: "memory");
}
__device__ __forceinline__ void p0_prologue(const Args& A, unsigned char* lds) {
    const int tid = threadIdx.x, lane = tid & 63, wave = tid >> 6;
    const int gw = blockIdx.x * NWAVES + wave, NGW = gridDim.x * NWAVES;
    float* scr = (float*)(lds + wave * 16640);
    const float* x = A.in[0]; const float* n1g = A.in[1]; const float* w_in = A.in[2]; const float* w_four = A.in[4]; const float* ag = A.in[5]; const float* fg = A.in[6];
    const float* w_out = A.in[7]; const float* n2g = A.in[8]; const float* w_up = A.in[9]; const float* w_down = A.in[12];
    bf16* WIN = (bf16*)(A.ws + WS_WIN); bf16* WOUT = (bf16*)(A.ws + WS_WOUT); bf16* WUP = (bf16*)(A.ws + WS_WUP); bf16* WDOWN = (bf16*)(A.ws + WS_WDOWN);
    constexpr int I_IN = 32 * 48, I_OUT = 32 * 32, I_UP = 32 * 172, I_DOWN = 86 * 32, NITEMS = I_IN + I_OUT + I_UP + I_DOWN;
    for (int it = gw; it < NITEMS; it += NGW) {
        int r = it;
        if (r < I_IN) { const int kb = r / 48, nb = r % 48; p0_item(w_in, DM, NIN, WIN, 64 * nb, n1g, scr, 64 * kb, 64 * nb, lane); continue; } r -= I_IN;
        if (r < I_OUT) { const int kb = r / 32, nb = r % 32; const int k0 = 64 * kb; p0_item(w_out, DM, DM, WOUT, 64 * nb, k0 < NQ ? ag : fg - NQ, scr, k0, 64 * nb, lane); continue; } r -= I_OUT;
        if (r < I_UP) { const int kb = r / 172, nb = r % 172; const int n0 = 64 * nb; int orow; if (n0 < DFF) orow = 256 * (n0 >> 7) + (n0 & 127); else { const int c = n0 - DFF; orow = 256 * (c >> 7) + 128 + (c & 127); }
            p0_item(w_up, DM, NUP, WUP, orow, n2g, scr, 64 * kb, n0, lane); continue; } r -= I_UP;
        { const int kb = r / 32, nb = r % 32; p0_item(w_down, DFF, DM, WDOWN, 64 * nb, nullptr, scr, 64 * kb, 64 * nb, lane); }
    }
    bf16* XB = (bf16*)(A.ws + WS_XB); float* RS1 = (float*)(A.ws + WS_RS1);
    for (int m = gw; m < SEQ; m += NGW) {
        const f32x4* xr = (const f32x4*)(x + (size_t)m * DM) + lane; f32x4 v[8]; float s = 0.f;
#pragma unroll
        for (int j = 0; j < 8; ++j) { v[j] = xr[64 * j]; s += (v[j][0] * v[j][0] + v[j][1] * v[j][1]) + (v[j][2] * v[j][2] + v[j][3] * v[j][3]); }
        s = wave_sum(s);
        u32x2* o8 = (u32x2*)(XB + (size_t)m * DM) + lane;
#pragma unroll
        for (int j = 0; j < 8; ++j) { u32x2 w; w.x = pk2(v[j][0], v[j][1]); w.y = pk2(v[j][2], v[j][3]); o8[64 * j] = w; }
        if (lane == 0) RS1[m] = 1.0f / sqrtf(s * (1.0f / DM) + RMS_EPS);
    }
    const int gt = blockIdx.x * NTHREADS + tid, NGT = gridDim.x * NTHREADS;
    bf16* W64 = (bf16*)(A.ws + WS_W64); bf16* BT3 = (bf16*)(A.ws + WS_BT3); bf16* WCS = (bf16*)(A.ws + WS_WCS);
    for (int i = gt; i < 128 * 64; i += NGT) { const int n = i >> 6, k = i & 63; float sn, cs; sincospif((float)((k * n) & 63) * (1.0f / 32.0f), &sn, &cs); W64[i] = (bf16)f2bf(n < 64 ? cs : -sn); }
    for (int i = gt; i < 256 * 256; i += NGT) { const int n = i >> 8, k = i & 255; const int k2 = n & 127, s2 = k & 127; float sn, cs; sincospif((float)((s2 * k2) & 127) * (1.0f / 64.0f), &sn, &cs);
        float v; if (n < 128) v = (k < 128) ? cs : sn; else v = (k < 128) ? -sn : cs; BT3[i] = (bf16)f2bf(v); }
    __syncthreads();
    float* trig = (float*)lds;
    if (tid < 128) { float sn, cs; sincospif((float)tid * (1.0f / 64.0f), &sn, &cs); trig[tid] = cs; trig[128 + tid] = sn; }
    __syncthreads();
    for (int i = gt; i < 4 * 128 * 256; i += NGT) { const int g = i >> 15, d = (i >> 8) & 127, k = i & 255, kk = k & 127; float a = 0.f; const float* tb = trig + (k < 128 ? 0 : 128);
#pragma unroll 8
        for (int c = 0; c < 128; ++c) a += tb[(kk * c) & 127] * w_four[(size_t)(g * 128 + c) * 128 + d];
        WCS[i] = (bf16)f2bf(a * (1.0f / 1024.0f)); }
    __syncthreads();
}

__device__ __forceinline__ float alibi_slope(int h) { return h < 8 ? exp2f(-(float)(h + 1)) : exp2f(-(0.5f + (float)(h - 8))); }
__device__ __forceinline__ void attn_phase(const Args& A, unsigned char* lds) {
    const int tid = threadIdx.x, lane = tid & 63, wid = tid >> 6, fr = lane & 15, g = lane >> 4;
    constexpr int RS = 272; constexpr float LOG2E = 1.4426950408889634f;
    unsigned char* Ks = lds; unsigned char* Vs = lds + 128 * RS;
    const bf16* Q = (const bf16*)(A.ws + WS_Q); const bf16* Kb = (const bf16*)(A.ws + WS_K); const bf16* VT = (const bf16*)(A.ws + WS_VT);
    bf16* MIX = (bf16*)(A.ws + WS_MIX); float* SSQA = (float*)(A.ws + WS_SSQA); const float* sink = A.in[3];
    for (int unit = blockIdx.x; unit < 768; unit += gridDim.x) {
        const int hq = unit % 12, nb = unit / 12, kvh = hq / 3;
        const int c_lo = nb > 0 ? nb - 1 : 0, c_hi = nb < 63 ? nb + 1 : 63;
        const int tq = 128 * nb + 16 * wid + fr;
        f32x4 o[8]; float mrun = sink[hq] * LOG2E, lrun = 1.f; const float slope2 = alibi_slope(hq) * LOG2E;
#pragma unroll
        for (int dt = 0; dt < 8; ++dt) o[dt] = (f32x4){0.f, 0.f, 0.f, 0.f};
        bf16x8 qf[4];
#pragma unroll
        for (int kk = 0; kk < 4; ++kk) qf[kk] = *(const bf16x8*)(Q + (size_t)tq * NQ + hq * 128 + 32 * kk + 8 * g);
        u32x4 pre[8];
        auto gload = [&](int c) {
#pragma unroll
            for (int i = 0; i < 4; ++i) { const int p = tid + 512 * i, row = p >> 4, c16 = p & 15;
                pre[i] = *(const u32x4*)(Kb + (size_t)(128 * c + row) * NKV + kvh * 128 + c16 * 8);
                pre[4 + i] = *(const u32x4*)(VT + (size_t)(kvh * 128 + row) * SEQ + 128 * c + c16 * 8); } };
        auto lstore = [&]() {
#pragma unroll
            for (int i = 0; i < 4; ++i) { const int p = tid + 512 * i, row = p >> 4, c16 = p & 15;
                *(u32x4*)(Ks + row * RS + c16 * 16) = pre[i]; *(u32x4*)(Vs + row * RS + c16 * 16) = pre[4 + i]; } };
        gload(c_lo); __syncthreads(); lstore(); __syncthreads();
        for (int c = c_lo; c <= c_hi; ++c) {
            if (c < c_hi) gload(c + 1);
            f32x4 s[8];
#pragma unroll
            for (int kt = 0; kt < 8; ++kt) { s[kt] = (f32x4){0.f, 0.f, 0.f, 0.f};
#pragma unroll
                for (int kk = 0; kk < 4; ++kk) { const bf16x8 a = *(const bf16x8*)(Ks + (16 * kt + fr) * RS + (32 * kk + 8 * g) * 2); s[kt] = MFMA16(a, qf[kk], s[kt]); } }
            float mx = -3.0e38f;
#pragma unroll
            for (int kt = 0; kt < 8; ++kt)
#pragma unroll
                for (int r = 0; r < 4; ++r) { const int rel = 128 * c + 16 * kt + 4 * g + r - tq; const int ar = rel < 0 ? -rel : rel;
                    float v = s[kt][r] - slope2 * (float)ar; if (ar > 128) v = -1.0e30f; s[kt][r] = v; mx = fmaxf(mx, v); }
            mx = fmaxf(mx, __shfl_xor(mx, 16)); mx = fmaxf(mx, __shfl_xor(mx, 32));
            const float mnew = fmaxf(mrun, mx); const float alpha = __builtin_amdgcn_exp2f(mrun - mnew); mrun = mnew;
            float sum = 0.f;
#pragma unroll
            for (int kt = 0; kt < 8; ++kt)
#pragma unroll
                for (int r = 0; r < 4; ++r) { const float p = __builtin_amdgcn_exp2f(s[kt][r] - mnew); s[kt][r] = p; sum += p; }
            sum += __shfl_xor(sum, 16); sum += __shfl_xor(sum, 32);
            lrun = lrun * alpha + sum;
#pragma unroll
            for (int dt = 0; dt < 8; ++dt) o[dt] *= alpha;
            bf16x8 pb[4];
#pragma unroll
            for (int ks = 0; ks < 4; ++ks) { u32x4 w; w.x = pk2(s[2 * ks][0], s[2 * ks][1]); w.y = pk2(s[2 * ks][2], s[2 * ks][3]); w.z = pk2(s[2 * ks + 1][0], s[2 * ks + 1][1]); w.w = pk2(s[2 * ks + 1][2], s[2 * ks + 1][3]); pb[ks] = __builtin_bit_cast(bf16x8, w); }
#pragma unroll
            for (int dt = 0; dt < 8; ++dt)
#pragma unroll
                for (int ks = 0; ks < 4; ++ks) { const bf16x8 a = *(const bf16x8*)(Vs + (16 * dt + fr) * RS + (32 * ks + 8 * g) * 2); o[dt] = MFMA16(a, pb[ks], o[dt]); }
            __syncthreads();
            if (c < c_hi) { lstore(); __syncthreads(); }
        }
        const float inv = 1.0f / lrun; float sq = 0.f;
#pragma unroll
        for (int dt = 0; dt < 8; ++dt) { const f32x4 v = o[dt] * inv; sq += (v[0] * v[0] + v[1] * v[1]) + (v[2] * v[2] + v[3] * v[3]);
            u32x2 w; w.x = pk2(v[0], v[1]); w.y = pk2(v[2], v[3]); *(u32x2*)(MIX + (size_t)tq * DM + hq * 128 + 16 * dt + 4 * g) = w; }
        sq += __shfl_xor(sq, 16); sq += __shfl_xor(sq, 32);
        if (g == 0) SSQA[(size_t)tq * 12 + hq] = sq;
    }
}
__device__ __forceinline__ void f1_phase(const Args& A) {
    const int tid = threadIdx.x, lane = tid & 63, wid = tid >> 6, fr = lane & 15, g = lane >> 4;
    const bf16* UP = (const bf16*)(A.ws + WS_UP); const bf16* W64 = (const bf16*)(A.ws + WS_W64); bf16* YB = (bf16*)(A.ws + WS_YB);
    const int gw = blockIdx.x * NWAVES + wid, NGW = gridDim.x * NWAVES;
    bf16x8 bfr[8][2];
#pragma unroll
    for (int nt = 0; nt < 8; ++nt)
#pragma unroll
        for (int kk = 0; kk < 2; ++kk) bfr[nt][kk] = *(const bf16x8*)(W64 + (16 * nt + fr) * 64 + 32 * kk + 8 * g);
    for (int rt = gw; rt < 4096; rt += NGW) {
        const int R0 = rt * 16, ch = R0 >> 7, s20 = R0 & 127;
        bf16x8 a[2];
#pragma unroll
        for (int kk = 0; kk < 2; ++kk) a[kk] = *(const bf16x8*)(UP + (size_t)(R0 + fr) * 64 + 32 * kk + 8 * g);
        f32x4 d[8];
#pragma unroll
        for (int nt = 0; nt < 8; ++nt) { d[nt] = (f32x4){0.f, 0.f, 0.f, 0.f};
#pragma unroll
            for (int kk = 0; kk < 2; ++kk) d[nt] = MFMA16(a[kk], bfr[nt][kk], d[nt]); }
#pragma unroll
        for (int nt = 0; nt < 4; ++nt) { const int k1 = 16 * nt + fr; float pr[4], pi[4];
#pragma unroll
            for (int r = 0; r < 4; ++r) { const int s2 = s20 + 4 * g + r; float sn, cs; sincospif((float)(s2 * k1) * (1.0f / 4096.0f), &sn, &cs);
                const float yr = d[nt][r], yi = d[nt + 4][r]; pr[r] = yr * cs + yi * sn; pi[r] = yi * cs - yr * sn; }
            bf16* dst = YB + (size_t)(ch * 64 + k1) * 256 + s20 + 4 * g;
            u32x2 w; w.x = pk2(pr[0], pr[1]); w.y = pk2(pr[2], pr[3]); *(u32x2*)dst = w;
            w.x = pk2(pi[0], pi[1]); w.y = pk2(pi[2], pi[3]); *(u32x2*)(dst + 128) = w; }
    }
}
__device__ __forceinline__ void f3_phase(const Args& A, unsigned char* lds) {
    const int tid = threadIdx.x, lane = tid & 63, wid = tid >> 6, fr = lane & 15, g = lane >> 4;
    const bf16* YB = (const bf16*)(A.ws + WS_YB); const bf16* BT3 = (const bf16*)(A.ws + WS_BT3); bf16* VB = (bf16*)(A.ws + WS_VB);
    constexpr int RS = 528;
    for (int i = 0; i < 16; ++i) { const int p = tid + 512 * i, row = p >> 5, c16 = p & 31; *(u32x4*)(lds + row * RS + c16 * 16) = *(const u32x4*)(BT3 + row * 256 + c16 * 8); }
    __syncthreads();
    for (int blk = blockIdx.x; blk < 256; blk += gridDim.x) {
        const int rt = blk * 8 + wid, k1 = rt >> 5, ch0 = (rt & 31) * 16;
        const bf16* ap = YB + (size_t)((ch0 + fr) * 64 + k1) * 256 + 8 * g;
        bf16x8 a[8];
#pragma unroll
        for (int kk = 0; kk < 8; ++kk) a[kk] = *(const bf16x8*)(ap + 32 * kk);
        const int grp = ch0 >> 7, cb = (ch0 & 127) + 4 * g;
#pragma unroll 4
        for (int nt = 0; nt < 16; ++nt) { f32x4 d = (f32x4){0.f, 0.f, 0.f, 0.f};
#pragma unroll
            for (int kk = 0; kk < 8; ++kk) { const bf16x8 b = *(const bf16x8*)(lds + (16 * nt + fr) * RS + (32 * kk + 8 * g) * 2); d = MFMA16(a[kk], b, d); }
            const int jc = 16 * nt + fr, k2 = jc & 127, im = jc >> 7, sp = k1 + 64 * k2;
            u32x2 w; w.x = pk2(d[0], d[1]); w.y = pk2(d[2], d[3]); *(u32x2*)(VB + (size_t)sp * 1024 + grp * 256 + im * 128 + cb) = w; }
    }
    __syncthreads();
}
__device__ __forceinline__ void f4_phase(const Args& A, unsigned char* lds) {
    const int tid = threadIdx.x, lane = tid & 63, wid = tid >> 6, fr = lane & 15, g = lane >> 4;
    const bf16* VB = (const bf16*)(A.ws + WS_VB); const bf16* WCS = (const bf16*)(A.ws + WS_WCS); bf16* MIX = (bf16*)(A.ws + WS_MIX);
    const float* SSQA = (const float*)(A.ws + WS_SSQA); float* RSA = (float*)(A.ws + WS_RSA);
    float* P = (float*)lds;
    const int g4 = wid & 3, half = wid >> 2;
    for (int blk = blockIdx.x; blk < 256; blk += gridDim.x) {
        const int sp = blk * 32 + half * 16 + fr;
        bf16x8 b[8];
#pragma unroll
        for (int kk = 0; kk < 8; ++kk) b[kk] = *(const bf16x8*)(VB + (size_t)sp * 1024 + g4 * 256 + 32 * kk + 8 * g);
        f32x4 o[8]; float sq = 0.f;
#pragma unroll
        for (int dt = 0; dt < 8; ++dt) { o[dt] = (f32x4){0.f, 0.f, 0.f, 0.f};
#pragma unroll
            for (int kk = 0; kk < 8; ++kk) { const bf16x8 a = *(const bf16x8*)(WCS + (size_t)(g4 * 128 + 16 * dt + fr) * 256 + 32 * kk + 8 * g); o[dt] = MFMA16(a, b[kk], o[dt]); }
            sq += (o[dt][0] * o[dt][0] + o[dt][1] * o[dt][1]) + (o[dt][2] * o[dt][2] + o[dt][3] * o[dt][3]); }
        sq += __shfl_xor(sq, 16); sq += __shfl_xor(sq, 32);
        if (g == 0) P[(half * 16 + fr) * 4 + g4] = sq;
        __syncthreads();
        const float* pp = P + (half * 16 + fr) * 4; const float tot = (pp[0] + pp[1]) + (pp[2] + pp[3]);
        const float rsf = 1.0f / sqrtf(tot * (1.0f / 512.0f) + RMS_EPS);
        float sa = 0.f;
#pragma unroll
        for (int h = 0; h < 12; ++h) sa += SSQA[(size_t)sp * 12 + h];
        const float rsa = 1.0f / sqrtf(sa * (1.0f / 1536.0f) + RMS_EPS);
        const float sc = rsf / rsa;
#pragma unroll
        for (int dt = 0; dt < 8; ++dt) { u32x2 w; w.x = pk2(o[dt][0] * sc, o[dt][1] * sc); w.y = pk2(o[dt][2] * sc, o[dt][3] * sc); *(u32x2*)(MIX + (size_t)sp * DM + NQ + g4 * 128 + 16 * dt + 4 * g) = w; }
        if (g4 == 0 && g == 0) RSA[sp] = rsa;
        __syncthreads();
    }
}
__device__ __forceinline__ void fixup_phase(const Args& A) {
    const float* edge = (const float*)(A.ws + WS_EDGE); const float* dww = A.in[10]; bf16* ACT = (bf16*)(A.ws + WS_ACT);
    const int gt = blockIdx.x * NTHREADS + threadIdx.x, NGT = gridDim.x * NTHREADS;
    for (int i = gt; i < 64 * (DFF / 4); i += NGT) { const int pe = i / (DFF / 4), c = (i % (DFF / 4)) * 4, pm = pe >> 1, e = pe & 1;
        const float* eb = edge + (size_t)(pe * 3) * DFF + c;
        f32x4 gp = *(const f32x4*)eb; const f32x4 V = *(const f32x4*)(eb + DFF);
        if (e == 0 && pm > 0) { const f32x4 G = *(const f32x4*)(edge + (size_t)(((pm - 1) * 2 + 1) * 3 + 2) * DFF + c); gp += *(const f32x4*)(dww + c) * G; }
        if (e == 1 && pm < 31) { const f32x4 G = *(const f32x4*)(edge + (size_t)(((pm + 1) * 2 + 0) * 3 + 2) * DFF + c); gp += *(const f32x4*)(dww + 2 * DFF + c) * G; }
        const pg8::f32x2 g0 = pg8::gelu_pk((pg8::f32x2){gp[0], gp[1]}), g1 = pg8::gelu_pk((pg8::f32x2){gp[2], gp[3]});
        const int row = 256 * pm + (e ? 255 : 0);
        u32x2 w; w.x = pk2(g0.x * V[0], g0.y * V[1]); w.y = pk2(g1.x * V[2], g1.y * V[3]); *(u32x2*)(ACT + (size_t)row * DFF + c) = w; }
}
__device__ __forceinline__ void final_phase(const Args& A) {
    const int tid = threadIdx.x, lane = tid & 63, wave = tid >> 6; const int gw = blockIdx.x * NWAVES + wave, NGW = gridDim.x * NWAVES;
    const float* SSQ2 = (const float*)(A.ws + WS_SSQ2); const float* ng = A.in[13];
    for (int m = gw; m < SEQ; m += NGW) {
        const f32x4 a = *(const f32x4*)(SSQ2 + (size_t)m * 8), b = *(const f32x4*)(SSQ2 + (size_t)m * 8 + 4);
        const float t = ((a[0] + a[1]) + (a[2] + a[3])) + ((b[0] + b[1]) + (b[2] + b[3])); const float rs = 1.0f / sqrtf(t * (1.0f / DM) + RMS_EPS);
        f32x4* xr = (f32x4*)(A.out + (size_t)m * DM) + lane; const f32x4* gr = (const f32x4*)ng + lane;
#pragma unroll
        for (int j = 0; j < 8; ++j) { const f32x4 v = xr[64 * j]; xr[64 * j] = v * rs * gr[64 * j]; }
    }
}

typedef __attribute__((address_space(1))) unsigned gu32;
#define RLX_AGENT __ATOMIC_RELAXED, __HIP_MEMORY_SCOPE_AGENT
#define XB_TMO      128
#define XB_XCNT(j)  (256  + 64 * (j))
#define XB_XSUB(j)  (1280 + 64 * (j))
#define XB_XGEN(j)  (2304 + 64 * (j))
#define XB_TOP      3328
#define XB_TOPGEN   3392
#define XCD_BAR_WORDS 3456
#define XB_SPIN_CAP (1u << 18)

__device__ __forceinline__ unsigned xb_ld(unsigned* p)              { return __hip_atomic_load(p, __ATOMIC_RELAXED, __HIP_MEMORY_SCOPE_AGENT); }
__device__ __forceinline__ unsigned xb_add(unsigned* p, unsigned v) { return __hip_atomic_fetch_add(p, v, __ATOMIC_RELAXED, __HIP_MEMORY_SCOPE_AGENT); }
__device__ __forceinline__ unsigned xb_xcc_id() { return (unsigned)__builtin_amdgcn_s_getreg((3 << 11) | 20) & 0xFu; }
#define XB_SPIN(cond, bar) do { unsigned _sp = 0; while (cond) { __builtin_amdgcn_s_sleep(1); \
    if ((++_sp & 255u) == 0u) { if (xb_ld(&(bar)[XB_TMO])) break; if (_sp > XB_SPIN_CAP) { atomicAdd(&(bar)[XB_TMO], 1u); break; } } } } while (0)

struct XcdBarrier {
    unsigned* bar; unsigned x;
    volatile LAS unsigned* st;
};

__device__ __forceinline__ XcdBarrier xcd_barrier_post(unsigned* bar, volatile LAS unsigned* st) {
    XcdBarrier b; b.bar = bar; b.x = xb_xcc_id(); b.st = st;
    if (threadIdx.x == 0) (void)xb_add(&bar[XB_XCNT(b.x)], 1u);
    return b;
}
__device__ __forceinline__ void xcd_barrier_complete(unsigned* bar, unsigned x, unsigned& nloc, unsigned& nx) {
    const unsigned G = gridDim.x * gridDim.y * gridDim.z;
    unsigned sum, cnt, mine, sp = 0u;
    for (;;) {
        sum = 0u; cnt = 0u; mine = 0u;
#pragma unroll
        for (unsigned j = 0; j < 16; ++j) { const unsigned c = xb_ld(&bar[XB_XCNT(j)]); sum += c; cnt += (c > 0u) ? 1u : 0u; mine = (j == x) ? c : mine; }
        if (sum == G) break;
        __builtin_amdgcn_s_sleep(1);
        if ((++sp & 255u) == 0u) { if (xb_ld(&bar[XB_TMO])) break; if (sp > XB_SPIN_CAP) { atomicAdd(&bar[XB_TMO], 1u); break; } }
    }
    nloc = mine > 0u ? mine : 1u; nx = cnt > 0u ? cnt : 1u;
}

__device__ __forceinline__ void xcd_barrier(const XcdBarrier& b) {
    asm volatile("s_waitcnt vmcnt(0)" ::: "memory");
    __syncthreads();
    if (threadIdx.x == 0) {
        unsigned* bar = b.bar;
        __builtin_amdgcn_s_waitcnt(0);
        unsigned nloc = b.st[0], nx = b.st[1];
        if (nloc == 0u) { xcd_barrier_complete(bar, b.x, nloc, nx); b.st[0] = nloc; b.st[1] = nx; }
        const unsigned old = xb_add(&bar[XB_XSUB(b.x)], 1u);
        const unsigned gen = old / nloc;
        if (old + 1u == (gen + 1u) * nloc) {
            __builtin_amdgcn_fence(__ATOMIC_RELEASE, "agent");
            asm volatile("s_waitcnt vmcnt(0)" ::: "memory");
            const unsigned og = xb_add(&bar[XB_TOP], 1u);
            const unsigned tg = og / nx;
            if (og + 1u == (tg + 1u) * nx) xb_add(&bar[XB_TOPGEN], 1u);
            else XB_SPIN(xb_ld(&bar[XB_TOPGEN]) == tg, bar);
            __builtin_amdgcn_fence(__ATOMIC_ACQUIRE, "agent");
            xb_add(&bar[XB_XGEN(b.x)], 1u);
            asm volatile("s_waitcnt vmcnt(0)" ::: "memory");
        } else {
            XB_SPIN(xb_ld(&bar[XB_XGEN(b.x)]) == gen, bar);
            __builtin_amdgcn_fence(__ATOMIC_ACQUIRE, "agent");
            asm volatile("s_waitcnt vmcnt(0)" ::: "memory");
        }
    }
    __syncthreads();
}

constexpr int NPHASE = 10;
__global__ void __launch_bounds__(NTHREADS, 2) fwd_mega(Args A) {
    extern __shared__ __attribute__((aligned(16))) unsigned char lds[];
    LAS unsigned char* ldsl = (LAS unsigned char*)lds;
    cg::grid_group grid = cg::this_grid();
    const int lo = A.ph_lo, hi = A.ph_hi;
    volatile LAS unsigned* MISC = (volatile LAS unsigned*)(ldsl + LDS_BYTES - 64);
    if (threadIdx.x < 16) MISC[threadIdx.x] = 0u;
    __syncthreads();
    XcdBarrier bar; bar.bar = (unsigned*)(A.ws + WS_CTL); bar.x = 0; bar.st = nullptr;
    if (hi - lo > 1) bar = xcd_barrier_post((unsigned*)(A.ws + WS_CTL), MISC + 8);
    if (hi > 1000) grid.sync();
#ifndef ONLY
#define ONLY -1
#endif
#define IN(k) ((ONLY < 0 || ONLY == (k)) && lo <= (k) && (k) < hi)
#ifndef REP_MASK
#define REP_MASK 0
#endif
#define REP(k) (((REP_MASK) >> (k)) & 1)
#define SEAM(k) do { if (IN(k) && IN((k) + 1)) xcd_barrier(bar); } while (0)
    unsigned char* ws = A.ws;
    const bf16* XB = (const bf16*)(ws + WS_XB); const float* RS1 = (const float*)(ws + WS_RS1);
    if (IN(0)) { p0_prologue(A, lds); if (REP(0)) { __syncthreads(); p0_prologue(A, lds); } } SEAM(0);
    if (IN(1)) {
        { pg8::Gemm gm{XB, (const bf16*)(ws + WS_WIN), SEQ, 2048, DM, 0}; pg8::StaticOrder S; S.init(SEQ, 2048, gridDim.x, blockIdx.x);
          pg8::EpiQK E{(bf16*)(ws + WS_Q), (bf16*)(ws + WS_K), RS1, 0.08838834764831845f * 1.4426950408889634f};
          pg8::gemm_phase<pg8::EpiQK, pg8::StaticOrder, true, true>(ldsl, gm, S, E); }
        { pg8::Gemm gm{(const bf16*)(ws + WS_WIN) + (size_t)2048 * DM, XB, 512, SEQ, DM, 0}; pg8::StaticOrder S; S.init(512, SEQ, gridDim.x, blockIdx.x);
          pg8::EpiVT E{(bf16*)(ws + WS_VT), RS1};
          pg8::gemm_phase<pg8::EpiVT, pg8::StaticOrder, true, true>(ldsl, gm, S, E); }
        { pg8::Gemm gm{(const bf16*)(ws + WS_WIN) + (size_t)2560 * DM, XB, 512, SEQ, DM, 1}; pg8::StaticOrder S; S.init(512, SEQ, gridDim.x, (int)((blockIdx.x + gridDim.x - 64) % gridDim.x));
          pg8::EpiUP E{(bf16*)(ws + WS_UP), RS1};
          pg8::gemm_phase<pg8::EpiUP, pg8::StaticOrder, true, true>(ldsl, gm, S, E); }
    } SEAM(1);
    if (IN(2)) { attn_phase(A, lds); if (REP(10)) { __syncthreads(); attn_phase(A, lds); } f1_phase(A); if (REP(11)) f1_phase(A); } SEAM(2);
    if (IN(3)) { f3_phase(A, lds); if (REP(3)) f3_phase(A, lds); } SEAM(3);
    if (IN(4)) { f4_phase(A, lds); if (REP(4)) f4_phase(A, lds); } SEAM(4);
    if (IN(5)) {
        pg8::Gemm gm{(const bf16*)(ws + WS_MIX), (const bf16*)(ws + WS_WOUT), SEQ, DM, DM, 0}; pg8::StaticOrder S; S.init(SEQ, DM, gridDim.x, blockIdx.x);
        pg8::EpiRes E{A.in[0], A.out, (bf16*)(ws + WS_X1B), (const float*)(ws + WS_RSA), (float*)(ws + WS_SSQ1), ldsl + SCR_OFF};
        pg8::gemm_phase<pg8::EpiRes, pg8::StaticOrder, true, true>(ldsl, gm, S, E);
    } SEAM(5);
    if (IN(6)) {
        pg8::Gemm gm{(const bf16*)(ws + WS_X1B), (const bf16*)(ws + WS_WUP), SEQ, NUP, DM, 0}; pg8::StaticOrder S; S.init(SEQ, NUP, gridDim.x, blockIdx.x);
        pg8::EpiUp E{(bf16*)(ws + WS_ACT), (const float*)(ws + WS_SSQ1), A.in[10], A.in[11], (float*)(ws + WS_EDGE), ldsl + SCR_OFF};
        pg8::gemm_phase<pg8::EpiUp, pg8::StaticOrder, true, true>(ldsl, gm, S, E);
        if (REP(6)) pg8::gemm_phase<pg8::EpiUp, pg8::StaticOrder, true, true>(ldsl, gm, S, E);
    } SEAM(6);
    if (IN(7)) { fixup_phase(A); } SEAM(7);
    if (IN(8)) {
        pg8::Gemm gm{(const bf16*)(ws + WS_ACT), (const bf16*)(ws + WS_WDOWN), SEQ, DM, DFF, 0}; pg8::StaticOrder S; S.init(SEQ, DM, gridDim.x, blockIdx.x);
        pg8::EpiRes E{A.out, A.out, nullptr, nullptr, (float*)(ws + WS_SSQ2), ldsl + SCR_OFF};
        pg8::gemm_phase<pg8::EpiRes, pg8::StaticOrder, true, true>(ldsl, gm, S, E);
    } SEAM(8);
    if (IN(9)) { final_phase(A); }
#undef IN
#undef SEAM
}

#ifndef MK_PER_PHASE
#define MK_PER_PHASE 0
#endif
extern "C" void kernel_launch(void* const* d_in, const int* in_sizes, int n_in, void* d_out, int out_size, void* d_ws, size_t ws_size, hipStream_t stream) {
    static int grid = 0;
    if (grid == 0) {
        if (n_in != 14 || out_size != SEQ * DM || ws_size < WS_END) { fprintf(stderr, "kernel_launch: unexpected shapes (n_in %d out %d ws %zu)\n", n_in, out_size, ws_size); grid = -1; return; }
        int dev = 0, cus = 0, per_cu = 0;
        (void)hipGetDevice(&dev); (void)hipDeviceGetAttribute(&cus, hipDeviceAttributeMultiprocessorCount, dev);
        (void)hipFuncSetAttribute((const void*)fwd_mega, hipFuncAttributeMaxDynamicSharedMemorySize, LDS_BYTES);
        if (hipOccupancyMaxActiveBlocksPerMultiprocessor(&per_cu, (const void*)fwd_mega, NTHREADS, LDS_BYTES) != hipSuccess || per_cu < 1) per_cu = 1;
        (void)hipGetLastError();
        grid = cus * 1;
        if (grid <= 0) grid = 256;
    }
    if (grid < 0) return;
    (void)hipMemsetAsync((unsigned char*)d_ws + WS_CTL, 0, CTL_BYTES, stream);
    Args a{};
    for (int i = 0; i < 14; ++i) a.in[i] = (const float*)d_in[i];
    a.out = (float*)d_out; a.ws = (unsigned char*)d_ws;
#if MK_PER_PHASE
    for (int p = 0; p < NPHASE; ++p) { a.ph_lo = p; a.ph_hi = p + 1; hipLaunchKernelGGL(fwd_mega, dim3(grid), dim3(NTHREADS), LDS_BYTES, stream, a); }
#else
    a.ph_lo = 0; a.ph_hi = NPHASE;
    void* args[] = {&a};
    hipError_t e = hipLaunchCooperativeKernel((const void*)fwd_mega, dim3(grid), dim3(NTHREADS), args, LDS_BYTES, stream);
    if (e != hipSuccess) fprintf(stderr, "cooperative launch failed: %s (grid %d)\n", hipGetErrorString(e), grid);
#endif
}
```

```cpp
#include <hip/hip_runtime.h>
#include <hip/hip_cooperative_groups.h>
#include <cstdio>
#include <cstdint>
namespace cg = cooperative_groups;
namespace pg8 {
#define PG8_LAS __attribute__((address_space(3)))
typedef unsigned short bf16_t;
typedef short bf16x8 __attribute__((ext_vector_type(8)));
typedef float f32x4 __attribute__((ext_vector_type(4)));
typedef unsigned u32x4 __attribute__((ext_vector_type(4)));
constexpr int BM = 256, BK = 64, HALF = 128, HTB = HALF * BK * 2  , STAGE_BYTES = 8 * HTB, NXCD = 8, WGM = 8;

__host__ __device__ __forceinline__ int lds_byte(int r, int c) { const int st = (r >> 4) * 2 + (c >> 5), rr = r & 15, cc = c & 31, ob = rr * 64 + cc * 2; return st * 1024 + (ob ^ (((ob >> 9) & 1) << 5)); }
__host__ __device__ __forceinline__ void stage_rc(int b, int& R, int& C) { const int st = b / 1024, sb = b % 1024, swz = sb ^ (((sb >> 9) & 1) << 5); R = (st >> 1) * 16 + swz / 64; C = (st & 1) * 32 + (swz % 64) / 2; }
__host__ __device__ __forceinline__ int perm32(int rho) { const int n = rho >> 4, i = rho & 15; return 8 * (i >> 2) + 4 * n + (i & 3); }

struct Unit { int pm, pn; };
struct Gemm { const bf16_t* A; const bf16_t* Bt; int M, N, K; int bmode; };

struct StaticOrder {
    int nM, nN, nwg, G, c;
    __host__ __device__ void init(int M, int N, int G_, int c_) { nM = M / BM; nN = N / BM; nwg = nM * nN; G = G_; c = c_; }
    __host__ __device__ bool next(int i, Unit& u) const {
        const long L = (long)i * G + c; if (L >= nwg) return false;
        int wgid = (int)L; { const int q = nwg / NXCD, r = nwg % NXCD, xcd = wgid % NXCD, off = wgid / NXCD; wgid = (xcd < r ? xcd * (q + 1) : r * (q + 1) + (xcd - r) * q) + off; }
        const int nig = WGM * nN, gid = wgid / nig, fm = gid * WGM, gsz = (nM - fm) < WGM ? (nM - fm) : WGM;
        u.pm = fm + ((wgid % nig) % gsz); u.pn = (wgid % nig) / gsz; return true;
    }
    __device__ __forceinline__ void a_ready(const Unit&) const {}
    __device__ __forceinline__ void done(const Unit&) const {}
};

__device__ __forceinline__ unsigned cvt_pk_bf16(float lo, float hi) { unsigned r; asm volatile("v_cvt_pk_bf16_f32 %0, %1, %2" : "=v"(r) : "v"(lo), "v"(hi)); return r; }
typedef float f32x2 __attribute__((ext_vector_type(2)));
typedef unsigned u32x2 __attribute__((ext_vector_type(2)));
__device__ __forceinline__ f32x2 gelu_pk(f32x2 v) {
    const f32x2 av = __builtin_elementwise_abs(v), d = av * 0.2316418882f + 1.0f;
    f32x2 t; t.x = __builtin_amdgcn_rcpf(d.x); t.y = __builtin_amdgcn_rcpf(d.y);
    f32x2 q = t * 0.5307027145f + (-0.7265760135f); q = q * t + 0.7107068705f; q = q * t + (-0.142248368f); q = q * t + 0.127414796f; q = q * t;
    const f32x2 s = (v * v) * (-0.72134752044f);
    f32x2 e; e.x = __builtin_amdgcn_exp2f(s.x); e.y = __builtin_amdgcn_exp2f(s.y);
    const f32x2 m = v * (q * e), r = v - m;
    f32x2 o; o.x = v.x < 0.f ? m.x : r.x; o.y = v.y < 0.f ? m.y : r.y; return o;
}
#define EPI_BAR() do { asm volatile("s_waitcnt lgkmcnt(0)" ::: "memory"); __builtin_amdgcn_s_barrier(); asm volatile("" ::: "memory"); } while (0)
constexpr float RMS_EPS = 1e-6f;

struct EpiQK {
    static constexpr bool PERM = true, AFTER_DRAIN = false;
    bf16_t* Q; bf16_t* Kb; const float* rs1; float qscale;
    __device__ __forceinline__ void operator()(f32x4 (&acc)[2][2][4][2], const Unit& u, int wr, int wc, int fr, int fq) const {
        const int row0 = u.pm * BM + wr * 64 + fr; const int colt = u.pn * BM;
        bf16_t* base; int ldc; float sc;
        if (colt < 1536) { base = Q + colt; ldc = 1536; sc = qscale; } else { base = Kb + (colt - 1536); ldc = 512; sc = 1.f; }
        const int col0 = wc * 32 + 8 * fq;
#pragma unroll
        for (int ai = 0; ai < 2; ++ai)
#pragma unroll
            for (int m = 0; m < 4; ++m) { const int row = row0 + ai * HALF + m * 16; const float s = rs1[row] * sc; bf16_t* rowp = base + (size_t)row * ldc + col0;
#pragma unroll
                for (int bj = 0; bj < 2; ++bj) { const f32x4 v0 = acc[ai][bj][m][0] * s, v1 = acc[ai][bj][m][1] * s;
                    u32x4 w; w.x = cvt_pk_bf16(v0[0], v0[1]); w.y = cvt_pk_bf16(v0[2], v0[3]); w.z = cvt_pk_bf16(v1[0], v1[1]); w.w = cvt_pk_bf16(v1[2], v1[3]);
                    *(u32x4*)(rowp + bj * HALF) = w; } }
    }
};
struct EpiVT {
    static constexpr bool PERM = false, AFTER_DRAIN = false;
    bf16_t* O; const float* rs1;
    __device__ __forceinline__ void operator()(f32x4 (&acc)[2][2][4][2], const Unit& u, int wr, int wc, int fr, int fq) const {
        const int row0 = u.pm * BM + wr * 64 + fr;
#pragma unroll
        for (int bj = 0; bj < 2; ++bj) {
            const int tok0 = u.pn * BM + bj * HALF + wc * 32 + 4 * fq;
            const f32x4 s0 = *(const f32x4*)(rs1 + tok0), s1 = *(const f32x4*)(rs1 + tok0 + 16);
            const int pos0 = u.pn * BM + bj * HALF + wc * 32 + 8 * fq;
#pragma unroll
            for (int ai = 0; ai < 2; ++ai)
#pragma unroll
                for (int m = 0; m < 4; ++m) { const int row = row0 + ai * HALF + m * 16; const f32x4 v0 = acc[ai][bj][m][0] * s0, v1 = acc[ai][bj][m][1] * s1;
                    u32x4 w; w.x = cvt_pk_bf16(v0[0], v0[1]); w.y = cvt_pk_bf16(v0[2], v0[3]); w.z = cvt_pk_bf16(v1[0], v1[1]); w.w = cvt_pk_bf16(v1[2], v1[3]);
                    *(u32x4*)(O + (size_t)row * 8192 + pos0) = w; }
        }
    }
};
struct EpiUP {
    static constexpr bool PERM = true, AFTER_DRAIN = false;
    bf16_t* O; const float* rs1;
    __device__ __forceinline__ void operator()(f32x4 (&acc)[2][2][4][2], const Unit& u, int wr, int wc, int fr, int fq) const {
        const int row0 = u.pm * BM + wr * 64 + fr;
#pragma unroll
        for (int bj = 0; bj < 2; ++bj) {
            const int s2 = 4 * u.pn + 2 * bj + (wc >> 1); const int s1b = 32 * (wc & 1) + 8 * fq;
            float sc[8];
#pragma unroll
            for (int e = 0; e < 8; ++e) sc[e] = rs1[128 * (s1b + e) + s2];
            const int pos0 = u.pn * BM + bj * HALF + wc * 32 + 8 * fq;
#pragma unroll
            for (int ai = 0; ai < 2; ++ai)
#pragma unroll
                for (int m = 0; m < 4; ++m) { const int row = row0 + ai * HALF + m * 16; const f32x4 v0 = acc[ai][bj][m][0], v1 = acc[ai][bj][m][1];
                    u32x4 w; w.x = cvt_pk_bf16(v0[0] * sc[0], v0[1] * sc[1]); w.y = cvt_pk_bf16(v0[2] * sc[2], v0[3] * sc[3]); w.z = cvt_pk_bf16(v1[0] * sc[4], v1[1] * sc[5]); w.w = cvt_pk_bf16(v1[2] * sc[6], v1[3] * sc[7]);
                    *(u32x4*)(O + (size_t)row * 8192 + pos0) = w; }
        }
    }
};
struct EpiRes {
    static constexpr bool PERM = false, AFTER_DRAIN = false;
    const float* base; float* out; bf16_t* outb; const float* rowscale; float* ssq; PG8_LAS unsigned char* scr;
    __device__ __forceinline__ void operator()(f32x4 (&acc)[2][2][4][2], const Unit& u, int wr, int wc, int fr, int fq) const {
        const int col0 = u.pn * BM + wc * 32 + 4 * fq;
        PG8_LAS float* P = (PG8_LAS float*)scr;
#pragma unroll
        for (int ai = 0; ai < 2; ++ai)
#pragma unroll
            for (int m = 0; m < 4; ++m) { const int r = ai * HALF + wr * 64 + m * 16 + fr; const int row = u.pm * BM + r; const float sc = rowscale ? rowscale[row] : 1.f; float s = 0.f;
#pragma unroll
                for (int bj = 0; bj < 2; ++bj)
#pragma unroll
                    for (int n = 0; n < 2; ++n) { const size_t off = (size_t)row * 2048 + col0 + bj * HALF + n * 16; const f32x4 b = *(const f32x4*)(base + off); const f32x4 o = b + acc[ai][bj][m][n] * sc;
                        *(f32x4*)(out + off) = o; s += (o[0] * o[0] + o[1] * o[1]) + (o[2] * o[2] + o[3] * o[3]);
                        if (outb) { u32x2 w; w.x = cvt_pk_bf16(o[0], o[1]); w.y = cvt_pk_bf16(o[2], o[3]); *(u32x2*)(outb + off) = w; } }
                s += __shfl_xor(s, 16); s += __shfl_xor(s, 32);
                if (fq == 0) P[r * 4 + wc] = s; }
        EPI_BAR();
        const int tid = threadIdx.x;
        if (tid < 256) { const f32x4 p = *(const PG8_LAS f32x4*)(P + tid * 4); ssq[(size_t)(u.pm * BM + tid) * 8 + u.pn] = (p[0] + p[1]) + (p[2] + p[3]); }
    }
};
struct EpiUp {
    static constexpr bool PERM = false, AFTER_DRAIN = false;
    bf16_t* act; const float* ssq1; const float* dww; const float* dwb; float* edge; PG8_LAS unsigned char* scr;
    __device__ __forceinline__ void operator()(f32x4 (&acc)[2][2][4][2], const Unit& u, int wr, int wc, int fr, int fq) const {
        const int lane = threadIdx.x & 63;
#pragma unroll
        for (int ai = 0; ai < 2; ++ai)
#pragma unroll
            for (int m = 0; m < 4; ++m) { const int row = u.pm * BM + ai * HALF + wr * 64 + m * 16 + fr; const f32x4 a = *(const f32x4*)(ssq1 + (size_t)row * 8), b = *(const f32x4*)(ssq1 + (size_t)row * 8 + 4);
                const float t = ((a[0] + a[1]) + (a[2] + a[3])) + ((b[0] + b[1]) + (b[2] + b[3])); const float rs = 1.0f / sqrtf(t * (1.0f / 2048.0f) + RMS_EPS);
#pragma unroll
                for (int bj = 0; bj < 2; ++bj)
#pragma unroll
                    for (int n = 0; n < 2; ++n) acc[ai][bj][m][n] *= rs; }
        PG8_LAS float* halo = (PG8_LAS float*)scr;
        const int cl = 32 * wc + 4 * fq;
#pragma unroll
        for (int ai = 0; ai < 2; ++ai) { const int seg = 2 * ai + wr;
            if (fr == 0) {
#pragma unroll
                for (int n = 0; n < 2; ++n) *(PG8_LAS f32x4*)(halo + (seg * 2 + 0) * 128 + cl + 16 * n) = acc[ai][0][0][n]; }
            if (fr == 15) {
#pragma unroll
                for (int n = 0; n < 2; ++n) *(PG8_LAS f32x4*)(halo + (seg * 2 + 1) * 128 + cl + 16 * n) = acc[ai][0][3][n]; } }
        EPI_BAR();
        const int c0 = 128 * u.pn + cl;
        const int src_up = (lane & 48) | ((fr + 15) & 15), src_dn = (lane & 48) | ((fr + 1) & 15);
#pragma unroll
        for (int n = 0; n < 2; ++n) {
            const f32x4 w0 = *(const f32x4*)(dww + c0 + 16 * n), w1 = *(const f32x4*)(dww + 5504 + c0 + 16 * n), w2 = *(const f32x4*)(dww + 11008 + c0 + 16 * n), bb = *(const f32x4*)(dwb + c0 + 16 * n);
#pragma unroll
            for (int ai = 0; ai < 2; ++ai) { const int seg = 2 * ai + wr;
                f32x4 hu = (f32x4){0.f, 0.f, 0.f, 0.f}, hd = (f32x4){0.f, 0.f, 0.f, 0.f};
                if (seg > 0) hu = *(const PG8_LAS f32x4*)(halo + ((seg - 1) * 2 + 1) * 128 + cl + 16 * n);
                if (seg < 3) hd = *(const PG8_LAS f32x4*)(halo + ((seg + 1) * 2 + 0) * 128 + cl + 16 * n);
#pragma unroll
                for (int m = 0; m < 4; ++m) {
                    const f32x4 G = acc[ai][0][m][n];
                    f32x4 xu = G, xd = G;
                    if (m > 0 && fr == 15) xu = acc[ai][0][m - 1][n];
                    if (m < 3 && fr == 0) xd = acc[ai][0][m + 1][n];
                    f32x4 U, D;
#pragma unroll
                    for (int e = 0; e < 4; ++e) { U[e] = __shfl(xu[e], src_up); D[e] = __shfl(xd[e], src_dn); }
                    if (m == 0 && fr == 0) U = hu;
                    if (m == 3 && fr == 15) D = hd;
                    const f32x4 gp = w0 * U + w1 * G + w2 * D + bb;
                    const f32x4 V = acc[ai][1][m][n];
                    const f32x2 g0 = gelu_pk((f32x2){gp[0], gp[1]}), g1 = gelu_pk((f32x2){gp[2], gp[3]});
                    const int row = u.pm * BM + ai * HALF + wr * 64 + m * 16 + fr;
                    u32x2 w; w.x = cvt_pk_bf16(g0.x * V[0], g0.y * V[1]); w.y = cvt_pk_bf16(g1.x * V[2], g1.y * V[3]);
                    *(u32x2*)(act + (size_t)row * 5504 + c0 + 16 * n) = w;
                    if (ai == 0 && m == 0 && wr == 0 && fr == 0) { float* e0 = edge + (size_t)((u.pm * 2 + 0) * 3) * 5504 + c0 + 16 * n;
                        *(f32x4*)(e0) = gp; *(f32x4*)(e0 + 5504) = V; *(f32x4*)(e0 + 2 * 5504) = G; }
                    if (ai == 1 && m == 3 && wr == 1 && fr == 15) { float* e1 = edge + (size_t)((u.pm * 2 + 1) * 3) * 5504 + c0 + 16 * n;
                        *(f32x4*)(e1) = gp; *(f32x4*)(e1 + 5504) = V; *(f32x4*)(e1 + 2 * 5504) = G; }
                }
            }
        }
    }
};
template <class Epi, class Sched, bool ALIGN_EPI = false, bool SP2 = false>
__device__ __forceinline__ void gemm_phase(PG8_LAS unsigned char* lds, const Gemm g, const Sched& S, const Epi& E) {
    const int tid = threadIdx.x, wid = __builtin_amdgcn_readfirstlane(tid >> 6), lane = tid & 63, wr = wid >> 2, wc = wid & 3, fr = lane & 15, fq = lane >> 4;
    const int K = g.K, nt = K / BK;
    unsigned voffA[2], voffB[2];
#pragma unroll
    for (int i = 0; i < 2; ++i) { int R, C; stage_rc(tid * 16 + i * 8192, R, C); const int Rb = Epi::PERM ? ((R & ~31) + perm32(R & 31)) : R;
        voffA[i] = (unsigned)(R * K + C) * 2u; voffB[i] = g.bmode ? (unsigned)(((Rb & 63) * 128 + (Rb >> 6)) * K + C) * 2u : (unsigned)(Rb * K + C) * 2u; }
    const size_t kstep = (size_t)(BK * 2);
    const size_t hstepA = (size_t)HALF * K * 2; const size_t hstepB = g.bmode ? (size_t)2 * K * 2 : hstepA;
    const size_t tstepA = 2 * hstepA; const size_t tstepB = 2 * hstepB;
    const unsigned ldsw = (unsigned)wid * 1024u;
    const int aoff = lds_byte(wr * 64 + fr, fq * 8), boff = lds_byte(wc * 32 + fr, fq * 8);
#define PG8_SA(b, h) (((b) * 2 + (h)) * HTB)
#define PG8_SB(b, h) ((4 + (b) * 2 + (h)) * HTB)
#define PG8_STAGE(bufoff, gbase, voff) do { _Pragma("unroll") for (int _i = 0; _i < 2; ++_i) \
        __builtin_amdgcn_global_load_lds((const unsigned*)((const char*)(gbase) + (voff)[_i]), (PG8_LAS unsigned*)(lds + (bufoff) + ldsw + _i * 8192), 16, 0, 0); } while (0)
#define PG8_LDA(dst, b, h) do { _Pragma("unroll") for (int m = 0; m < 4; ++m) _Pragma("unroll") for (int k = 0; k < 2; ++k) dst[m][k] = *(const PG8_LAS bf16x8*)(lds + PG8_SA(b, h) + aoff + m * 2048 + k * 1024); } while (0)
#define PG8_LDB(dst, b, h) do { _Pragma("unroll") for (int n = 0; n < 2; ++n) _Pragma("unroll") for (int k = 0; k < 2; ++k) dst[n][k] = *(const PG8_LAS bf16x8*)(lds + PG8_SB(b, h) + boff + n * 2048 + k * 1024); } while (0)
#define PG8_MMA(ai, bj, At, Bt) do { __builtin_amdgcn_s_setprio(1); _Pragma("unroll") for (int m = 0; m < 4; ++m) _Pragma("unroll") for (int n = 0; n < 2; ++n) _Pragma("unroll") for (int k = 0; k < 2; ++k) \
        acc[ai][bj][m][n] = __builtin_amdgcn_mfma_f32_16x16x32_bf16(Bt[n][k], At[m][k], acc[ai][bj][m][n], 0, 0, 0); __builtin_amdgcn_s_setprio(0); } while (0)
#define PG8_WAIT_V(n) asm volatile("s_waitcnt vmcnt(" #n ")" ::: "memory")
#define PG8_WAIT_L(n) asm volatile("s_waitcnt lgkmcnt(" #n ")" ::: "memory")
#define PG8_BAR __builtin_amdgcn_s_barrier()
#define PG8_SCHED __builtin_amdgcn_sched_barrier(0)
    Unit cur, nxt; int ui = 0;
    if (!S.next(0, cur)) return;
    f32x4 acc[2][2][4][2];
#pragma unroll
    for (int a = 0; a < 2; ++a)
#pragma unroll
        for (int b = 0; b < 2; ++b)
#pragma unroll
            for (int m = 0; m < 4; ++m)
#pragma unroll
                for (int n = 0; n < 2; ++n) acc[a][b][m][n] = (f32x4){0.f, 0.f, 0.f, 0.f};
    bf16x8 At[4][2], B0[2][2], B1[2][2];
    const char* cA = (const char*)g.A + (size_t)cur.pm * tstepA; const char* cB = (const char*)g.Bt + (size_t)cur.pn * tstepB;
    S.a_ready(cur);
    if constexpr (SP2) {
        PG8_STAGE(PG8_SB(0, 0), cB, voffB); PG8_STAGE(PG8_SB(0, 1), cB + hstepB, voffB); PG8_STAGE(PG8_SA(0, 0), cA, voffA); PG8_STAGE(PG8_SA(0, 1), cA + hstepA, voffA);
        if (wr == 1) PG8_BAR;
        PG8_WAIT_V(2); PG8_BAR;
        PG8_STAGE(PG8_SB(1, 0), cB + kstep, voffB); PG8_STAGE(PG8_SA(1, 0), cA + kstep, voffA); PG8_STAGE(PG8_SB(1, 1), cB + hstepB + kstep, voffB);
        PG8_WAIT_V(6); PG8_BAR;
    } else {
        PG8_STAGE(PG8_SB(0, 0), cB, voffB); PG8_STAGE(PG8_SA(0, 0), cA, voffA); PG8_STAGE(PG8_SB(0, 1), cB + hstepB, voffB); PG8_STAGE(PG8_SA(0, 1), cA + hstepA, voffA);
        if (wr == 1) PG8_BAR;
        PG8_WAIT_V(4); PG8_BAR;
        PG8_STAGE(PG8_SB(1, 0), cB + kstep, voffB); PG8_STAGE(PG8_SA(1, 0), cA + kstep, voffA); PG8_STAGE(PG8_SB(1, 1), cB + hstepB + kstep, voffB);
        PG8_WAIT_V(6); PG8_BAR;
    }
    for (;;) {
        const bool has_next = S.next(ui + 1, nxt);
        const char* nA = has_next ? (const char*)g.A + (size_t)nxt.pm * tstepA : cA; const char* nB = has_next ? (const char*)g.Bt + (size_t)nxt.pn * tstepB : cB;
        for (int t = 0; t < nt; t += 2) {
            const bool last = (t == nt - 2);
            const char* a1 = cA + (size_t)(t + 1) * kstep;
            const char* a2 = last ? nA : cA + (size_t)(t + 2) * kstep; const char* b2 = last ? nB : cB + (size_t)(t + 2) * kstep;
            const char* a3 = a2 + kstep; const char* b3 = b2 + kstep;
            if (last && has_next) S.a_ready(nxt);
            if constexpr (SP2) {
            PG8_LDB(B0, 0, 0); PG8_LDB(B1, 0, 1); PG8_SCHED; PG8_LDA(At, 0, 0); PG8_STAGE(PG8_SA(1, 1), a1 + hstepA, voffA);
            PG8_WAIT_V(8); PG8_WAIT_L(0); PG8_BAR; PG8_MMA(0, 0, At, B0); PG8_MMA(0, 1, At, B1); PG8_BAR; PG8_SCHED;
            PG8_LDA(At, 0, 1); PG8_STAGE(PG8_SB(0, 0), b2, voffB); PG8_STAGE(PG8_SB(0, 1), b2 + hstepB, voffB); PG8_STAGE(PG8_SA(0, 0), a2, voffA);
            PG8_WAIT_V(8); PG8_WAIT_L(0); PG8_BAR; PG8_MMA(1, 0, At, B0); PG8_MMA(1, 1, At, B1); PG8_BAR; PG8_SCHED;
            PG8_LDB(B0, 1, 0); PG8_LDB(B1, 1, 1); PG8_SCHED; PG8_LDA(At, 1, 0); PG8_STAGE(PG8_SA(0, 1), a2 + hstepA, voffA);
            PG8_WAIT_V(8); PG8_WAIT_L(0); PG8_BAR; PG8_MMA(0, 0, At, B0); PG8_MMA(0, 1, At, B1); PG8_BAR; PG8_SCHED;
            PG8_LDA(At, 1, 1); PG8_STAGE(PG8_SB(1, 0), b3, voffB); PG8_STAGE(PG8_SB(1, 1), b3 + hstepB, voffB); PG8_STAGE(PG8_SA(1, 0), a3, voffA);
            PG8_WAIT_V(8); PG8_WAIT_L(0); PG8_BAR; PG8_MMA(1, 0, At, B0); PG8_MMA(1, 1, At, B1); PG8_BAR; PG8_SCHED;
            } else {
            PG8_LDB(B0, 0, 0); PG8_SCHED; PG8_LDA(At, 0, 0); PG8_STAGE(PG8_SA(1, 1), a1 + hstepA, voffA);
            PG8_WAIT_L(8); PG8_BAR; PG8_WAIT_L(0); PG8_MMA(0, 0, At, B0); PG8_BAR; PG8_SCHED;
            PG8_LDB(B1, 0, 1); PG8_STAGE(PG8_SB(0, 0), b2, voffB);
            PG8_BAR; PG8_WAIT_L(0); PG8_MMA(0, 1, At, B1); PG8_BAR;
            PG8_LDA(At, 0, 1); PG8_STAGE(PG8_SA(0, 0), a2, voffA);
            PG8_BAR; PG8_WAIT_L(0); PG8_MMA(1, 0, At, B0); PG8_BAR; PG8_SCHED;
            PG8_STAGE(PG8_SB(0, 1), b2 + hstepB, voffB);
            PG8_WAIT_V(6); PG8_BAR; PG8_MMA(1, 1, At, B1); PG8_BAR;
            PG8_LDB(B0, 1, 0); PG8_SCHED; PG8_LDA(At, 1, 0); PG8_STAGE(PG8_SA(0, 1), a2 + hstepA, voffA);
            PG8_WAIT_L(8); PG8_BAR; PG8_WAIT_L(0); PG8_MMA(0, 0, At, B0); PG8_BAR; PG8_SCHED;
            PG8_LDB(B1, 1, 1); PG8_STAGE(PG8_SB(1, 0), b3, voffB);
            PG8_BAR; PG8_WAIT_L(0); PG8_MMA(0, 1, At, B1); PG8_BAR;
            PG8_LDA(At, 1, 1); PG8_STAGE(PG8_SA(1, 0), a3, voffA);
            PG8_BAR; PG8_WAIT_L(0); PG8_MMA(1, 0, At, B0); PG8_BAR; PG8_SCHED;
            PG8_STAGE(PG8_SB(1, 1), b3 + hstepB, voffB);
            PG8_WAIT_V(6); PG8_BAR; PG8_MMA(1, 1, At, B1); PG8_BAR;
            }
        }
        if constexpr (ALIGN_EPI) { if (wr == 0) PG8_BAR; }
        if constexpr (!Epi::AFTER_DRAIN) { E(acc, cur, wr, wc, fr, fq); S.done(cur); }
        if (!has_next) break;
#pragma unroll
        for (int a = 0; a < 2; ++a)
#pragma unroll
            for (int b = 0; b < 2; ++b)
#pragma unroll
                for (int m = 0; m < 4; ++m)
#pragma unroll
                    for (int n = 0; n < 2; ++n) acc[a][b][m][n] = (f32x4){0.f, 0.f, 0.f, 0.f};
        cur = nxt; cA = nA; cB = nB; ++ui;
        if constexpr (ALIGN_EPI) { if (wr == 1) PG8_BAR; }
    }
    PG8_WAIT_V(0);
    if constexpr (!ALIGN_EPI) { if (wr == 0) PG8_BAR; }
    PG8_BAR;
    if constexpr (Epi::AFTER_DRAIN) { E.fused(acc, cur, wr, wc, fr, fq, lds, wid, lane); S.done(cur); }
#undef PG8_SA
#undef PG8_SB
#undef PG8_STAGE
#undef PG8_LDA
#undef PG8_LDB
#undef PG8_MMA
#undef PG8_WAIT_V
#undef PG8_WAIT_L
#undef PG8_BAR
#undef PG8_SCHED
}
}
constexpr int SEQ = 8192, DM = 2048, NQ = 1536, NKV = 512, NFO = 512, NIN = 3072, DFF = 5504, NUP = 11008;
using pg8::RMS_EPS;
constexpr size_t MiB = 1u << 20;
constexpr size_t WS_WIN = 0, WS_WOUT = 12 * MiB, WS_WUP = 20 * MiB, WS_WDOWN = 63 * MiB;
constexpr size_t WS_XB = 85 * MiB, WS_Q = 117 * MiB, WS_K = 141 * MiB, WS_VT = 149 * MiB, WS_UP = 157 * MiB, WS_MIX = 165 * MiB, WS_YB = 197 * MiB, WS_VB = 213 * MiB;
constexpr size_t WS_ACT = 85 * MiB;
constexpr size_t WS_SMALL = 229 * MiB;
constexpr size_t WS_RS1 = WS_SMALL, WS_RSA = WS_SMALL + 32768, WS_SSQA = WS_SMALL + 65536, WS_SSQ1 = WS_SMALL + 524288, WS_SSQ2 = WS_SMALL + 786432;
constexpr size_t WS_W64 = WS_SMALL + 1048576, WS_BT3 = WS_SMALL + 1114112, WS_WCS = WS_SMALL + 1310720, WS_EDGE = WS_SMALL + 2 * MiB;
constexpr size_t WS_CTL = WS_SMALL + 8 * MiB, CTL_BYTES = 16384;
constexpr size_t WS_X1B = 240 * MiB, WS_END = 272 * MiB;
static_assert(WS_ACT + (size_t)SEQ * DFF * 2 <= WS_YB + 16 * MiB && WS_EDGE + (size_t)64 * 3 * DFF * 4 <= WS_X1B, "ws map");
constexpr int RING_BYTES = 131072, SCR_OFF = RING_BYTES + 512, LDS_BYTES = 147456;
constexpr int NWAVES = 8, NTHREADS = 512;
#define LAS __attribute__((address_space(3)))
typedef unsigned short bf16;
typedef float f32x4 __attribute__((ext_vector_type(4)));
typedef short bf16x8 __attribute__((ext_vector_type(8)));
typedef unsigned u32x4 __attribute__((ext_vector_type(4)));
typedef unsigned u32x2 __attribute__((ext_vector_type(2)));
__device__ __forceinline__ unsigned f2bf(float f) { unsigned u = __builtin_bit_cast(unsigned, f); return (u + 0x7fffu + ((u >> 16) & 1u)) >> 16; }
__device__ __forceinline__ unsigned pk2(float lo, float hi) { return f2bf(lo) | (f2bf(hi) << 16); }
__device__ __forceinline__ float wave_sum(float v) {
#pragma unroll
    for (int o = 1; o < 64; o <<= 1) v += __shfl_xor(v, o);
    return v;
}
#define MFMA16(a, b, c) __builtin_amdgcn_mfma_f32_16x16x32_bf16((a), (b), (c), 0, 0, 0)

struct Args { const float* in[14]; float* out; unsigned char* ws; int ph_lo, ph_hi; };

__device__ __forceinline__ void p0_item(const float* W, int K, int N, bf16* WT, int out_row0, const float* ksc, float* scr, int k0, int n0, int lane) {
    const int kr = lane >> 4, nc = (lane & 15) * 4;
    f32x4 v[16];
#pragma unroll
    for (int i = 0; i < 16; ++i) v[i] = *(const f32x4*)(W + (size_t)(k0 + 4 * i + kr) * N + n0 + nc);
#pragma unroll
    for (int i = 0; i < 16; ++i) { const float sc = ksc ? ksc[k0 + 4 * i + kr] : 1.f; float* d = scr + (4 * i + kr) * 65 + nc; d[0] = v[i][0] * sc; d[1] = v[i][1] * sc; d[2] = v[i][2] * sc; d[3] = v[i][3] * sc; }
    asm volatile("s_waitcnt lgkmcnt(0)" ::: "memory");
    const int c = lane & 7;
#pragma unroll
    for (int j = 0; j < 8; ++j) { const int n = (lane >> 3) + 8 * j; const float* s = scr + (8 * c) * 65 + n;
        u32x4 o; o.x = pk2(s[0 * 65], s[1 * 65]); o.y = pk2(s[2 * 65], s[3 * 65]); o.z = pk2(s[4 * 65], s[5 * 65]); o.w = pk2(s[6 * 65], s[7 * 65]);
        *(u32x4*)(WT + (size_t)(out_row0 + n) * K + k0 + 8 * c) = o; }
    asm volatile("s_waitcnt lgkmcnt(0)" ::: "memory");
}
__device__ __forceinline__ void p0_weights(const Args& A, unsigned char* lds, int part, int gw, int NGW) {
    const int tid = threadIdx.x, lane = tid & 63, wave = tid >> 6;
    float* scr = (float*)(lds + wave * 16640);
    const float* n1g = A.in[1]; const float* w_in = A.in[2]; const float* ag = A.in[5]; const float* fg = A.in[6];
    const float* w_out = A.in[7]; const float* n2g = A.in[8]; const float* w_up = A.in[9]; const float* w_down = A.in[12];
    bf16* WIN = (bf16*)(A.ws + WS_WIN); bf16* WOUT = (bf16*)(A.ws + WS_WOUT); bf16* WUP = (bf16*)(A.ws + WS_WUP); bf16* WDOWN = (bf16*)(A.ws + WS_WDOWN);
    constexpr int I_IN = 32 * 48, I_OUT = 32 * 32, I_UP = 32 * 172, I_DOWN = 86 * 32;
    if (part == 0) {
        for (int r = gw; r < I_IN; r += NGW) { const int kb = r / 48, nb = r % 48; p0_item(w_in, DM, NIN, WIN, 64 * nb, n1g, scr, 64 * kb, 64 * nb, lane); }
        return;
    }
    for (int it = gw; it < I_OUT + I_UP + I_DOWN; it += NGW) {
        int r = it;
        if (r < I_OUT) { const int kb = r / 32, nb = r % 32; const int k0 = 64 * kb; p0_item(w_out, DM, DM, WOUT, 64 * nb, k0 < NQ ? ag : fg - NQ, scr, k0, 64 * nb, lane); continue; } r -= I_OUT;
        if (r < I_UP) { const int kb = r / 172, nb = r % 172; const int n0 = 64 * nb; int orow; if (n0 < DFF) orow = 256 * (n0 >> 7) + (n0 & 127); else { const int c = n0 - DFF; orow = 256 * (c >> 7) + 128 + (c & 127); }
            p0_item(w_up, DM, NUP, WUP, orow, n2g, scr, 64 * kb, n0, lane); continue; } r -= I_UP;
        { const int kb = r / 32, nb = r % 32; p0_item(w_down, DFF, DM, WDOWN, 64 * nb, nullptr, scr, 64 * kb, 64 * nb, lane); }
    }
}
__device__ __forceinline__ void p0_prologue(const Args& A, unsigned char* lds) {
    const int tid = threadIdx.x, lane = tid & 63, wave = tid >> 6;
    const int gw = blockIdx.x * NWAVES + wave, NGW = gridDim.x * NWAVES;
    const float* x = A.in[0]; const float* w_four = A.in[4];
    p0_weights(A, lds, 0, gw, NGW);
    bf16* XB = (bf16*)(A.ws + WS_XB); float* RS1 = (float*)(A.ws + WS_RS1);
    for (int m = gw; m < SEQ; m += NGW) {
        const f32x4* xr = (const f32x4*)(x + (size_t)m * DM) + lane; f32x4 v[8]; float s = 0.f;
#pragma unroll
        for (int j = 0; j < 8; ++j) { v[j] = xr[64 * j]; s += (v[j][0] * v[j][0] + v[j][1] * v[j][1]) + (v[j][2] * v[j][2] + v[j][3] * v[j][3]); }
        s = wave_sum(s);
        u32x2* o8 = (u32x2*)(XB + (size_t)m * DM) + lane;
#pragma unroll
        for (int j = 0; j < 8; ++j) { u32x2 w; w.x = pk2(v[j][0], v[j][1]); w.y = pk2(v[j][2], v[j][3]); o8[64 * j] = w; }
        if (lane == 0) RS1[m] = 1.0f / sqrtf(s * (1.0f / DM) + RMS_EPS);
    }
    const int gt = blockIdx.x * NTHREADS + tid, NGT = gridDim.x * NTHREADS;
    bf16* W64 = (bf16*)(A.ws + WS_W64); bf16* BT3 = (bf16*)(A.ws + WS_BT3); bf16* WCS = (bf16*)(A.ws + WS_WCS);
    for (int i = gt; i < 128 * 64; i += NGT) { const int n = i >> 6, k = i & 63; float sn, cs; sincospif((float)((k * n) & 63) * (1.0f / 32.0f), &sn, &cs); W64[i] = (bf16)f2bf(n < 64 ? cs : -sn); }
    for (int i = gt; i < 256 * 256; i += NGT) { const int n = i >> 8, k = i & 255; const int k2 = n & 127, s2 = k & 127; float sn, cs; sincospif((float)((s2 * k2) & 127) * (1.0f / 64.0f), &sn, &cs);
        float v; if (n < 128) v = (k < 128) ? cs : sn; else v = (k < 128) ? -sn : cs; BT3[i] = (bf16)f2bf(v); }
    __syncthreads();
    float* trig = (float*)lds;
    if (tid < 128) { float sn, cs; sincospif((float)tid * (1.0f / 64.0f), &sn, &cs); trig[tid] = cs; trig[128 + tid] = sn; }
    __syncthreads();
    for (int i = gt; i < 4 * 128 * 256; i += NGT) { const int g = i >> 15, d = (i >> 8) & 127, k = i & 255, kk = k & 127; float a = 0.f; const float* tb = trig + (k < 128 ? 0 : 128);
#pragma unroll 8
        for (int c = 0; c < 128; ++c) a += tb[(kk * c) & 127] * w_four[(size_t)(g * 128 + c) * 128 + d];
        WCS[i] = (bf16)f2bf(a * (1.0f / 1024.0f)); }
    __syncthreads();
}

__device__ __forceinline__ float alibi_slope(int h) { return h < 8 ? exp2f(-(float)(h + 1)) : exp2f(-(0.5f + (float)(h - 8))); }
__device__ __forceinline__ void attn_phase(const Args& A, unsigned char* lds) {
    const int tid = threadIdx.x, lane = tid & 63, wid = tid >> 6, fr = lane & 15, g = lane >> 4;
    constexpr int RS = 272; constexpr float LOG2E = 1.4426950408889634f;
    unsigned char* Ks = lds; unsigned char* Vs = lds + 128 * RS;
    const bf16* Q = (const bf16*)(A.ws + WS_Q); const bf16* Kb = (const bf16*)(A.ws + WS_K); const bf16* VT = (const bf16*)(A.ws + WS_VT);
    bf16* MIX = (bf16*)(A.ws + WS_MIX); float* SSQA = (float*)(A.ws + WS_SSQA); const float* sink = A.in[3];
    for (int unit = blockIdx.x; unit < 768; unit += gridDim.x) {
        const int hq = unit % 12, nb = unit / 12, kvh = hq / 3;
        const int c_lo = nb > 0 ? nb - 1 : 0, c_hi = nb < 63 ? nb + 1 : 63;
        const int tq = 128 * nb + 16 * wid + fr;
        f32x4 o[8]; float mrun = sink[hq] * LOG2E, lrun = 1.f; const float slope2 = alibi_slope(hq) * LOG2E;
#pragma unroll
        for (int dt = 0; dt < 8; ++dt) o[dt] = (f32x4){0.f, 0.f, 0.f, 0.f};
        bf16x8 qf[4];
#pragma unroll
        for (int kk = 0; kk < 4; ++kk) qf[kk] = *(const bf16x8*)(Q + (size_t)tq * NQ + hq * 128 + 32 * kk + 8 * g);
        u32x4 pre[8];
        auto gload = [&](int c) {
#pragma unroll
            for (int i = 0; i < 4; ++i) { const int p = tid + 512 * i, row = p >> 4, c16 = p & 15;
                pre[i] = *(const u32x4*)(Kb + (size_t)(128 * c + row) * NKV + kvh * 128 + c16 * 8);
                pre[4 + i] = *(const u32x4*)(VT + (size_t)(kvh * 128 + row) * SEQ + 128 * c + c16 * 8); } };
        auto lstore = [&]() {
#pragma unroll
            for (int i = 0; i < 4; ++i) { const int p = tid + 512 * i, row = p >> 4, c16 = p & 15;
                *(u32x4*)(Ks + row * RS + c16 * 16) = pre[i]; *(u32x4*)(Vs + row * RS + c16 * 16) = pre[4 + i]; } };
        gload(c_lo); __syncthreads(); lstore(); __syncthreads();
        for (int c = c_lo; c <= c_hi; ++c) {
            if (c < c_hi) gload(c + 1);
            f32x4 s[8];
#pragma unroll
            for (int kt = 0; kt < 8; ++kt) { s[kt] = (f32x4){0.f, 0.f, 0.f, 0.f};
#pragma unroll
                for (int kk = 0; kk < 4; ++kk) { const bf16x8 a = *(const bf16x8*)(Ks + (16 * kt + fr) * RS + (32 * kk + 8 * g) * 2); s[kt] = MFMA16(a, qf[kk], s[kt]); } }
            float mx = -3.0e38f;
#pragma unroll
            for (int kt = 0; kt < 8; ++kt)
#pragma unroll
                for (int r = 0; r < 4; ++r) { const int rel = 128 * c + 16 * kt + 4 * g + r - tq; const int ar = rel < 0 ? -rel : rel;
                    float v = s[kt][r] - slope2 * (float)ar; if (ar > 128) v = -1.0e30f; s[kt][r] = v; mx = fmaxf(mx, v); }
            mx = fmaxf(mx, __shfl_xor(mx, 16)); mx = fmaxf(mx, __shfl_xor(mx, 32));
            const float mnew = fmaxf(mrun, mx); const float alpha = __builtin_amdgcn_exp2f(mrun - mnew); mrun = mnew;
            float sum = 0.f;
#pragma unroll
            for (int kt = 0; kt < 8; ++kt)
#pragma unroll
                for (int r = 0; r < 4; ++r) { const float p = __builtin_amdgcn_exp2f(s[kt][r] - mnew); s[kt][r] = p; sum += p; }
            sum += __shfl_xor(sum, 16); sum += __shfl_xor(sum, 32);
            lrun = lrun * alpha + sum;
#pragma unroll
            for (int dt = 0; dt < 8; ++dt) o[dt] *= alpha;
            bf16x8 pb[4];
#pragma unroll
            for (int ks = 0; ks < 4; ++ks) { u32x4 w; w.x = pk2(s[2 * ks][0], s[2 * ks][1]); w.y = pk2(s[2 * ks][2], s[2 * ks][3]); w.z = pk2(s[2 * ks + 1][0], s[2 * ks + 1][1]); w.w = pk2(s[2 * ks + 1][2], s[2 * ks + 1][3]); pb[ks] = __builtin_bit_cast(bf16x8, w); }
#pragma unroll
            for (int dt = 0; dt < 8; ++dt)
#pragma unroll
                for (int ks = 0; ks < 4; ++ks) { const bf16x8 a = *(const bf16x8*)(Vs + (16 * dt + fr) * RS + (32 * ks + 8 * g) * 2); o[dt] = MFMA16(a, pb[ks], o[dt]); }
            __syncthreads();
            if (c < c_hi) { lstore(); __syncthreads(); }
        }
        const float inv = 1.0f / lrun; float sq = 0.f;
#pragma unroll
        for (int dt = 0; dt < 8; ++dt) { const f32x4 v = o[dt] * inv; sq += (v[0] * v[0] + v[1] * v[1]) + (v[2] * v[2] + v[3] * v[3]);
            u32x2 w; w.x = pk2(v[0], v[1]); w.y = pk2(v[2], v[3]); *(u32x2*)(MIX + (size_t)tq * DM + hq * 128 + 16 * dt + 4 * g) = w; }
        sq += __shfl_xor(sq, 16); sq += __shfl_xor(sq, 32);
        if (g == 0) SSQA[(size_t)tq * 12 + hq] = sq;
    }
}
__device__ __forceinline__ void f1_phase(const Args& A) {
    const int tid = threadIdx.x, lane = tid & 63, wid = tid >> 6, fr = lane & 15, g = lane >> 4;
    const bf16* UP = (const bf16*)(A.ws + WS_UP); const bf16* W64 = (const bf16*)(A.ws + WS_W64); bf16* YB = (bf16*)(A.ws + WS_YB);
    const int gw = blockIdx.x * NWAVES + wid, NGW = gridDim.x * NWAVES;
    bf16x8 bfr[8][2];
#pragma unroll
    for (int nt = 0; nt < 8; ++nt)
#pragma unroll
        for (int kk = 0; kk < 2; ++kk) bfr[nt][kk] = *(const bf16x8*)(W64 + (16 * nt + fr) * 64 + 32 * kk + 8 * g);
    for (int rt = gw; rt < 4096; rt += NGW) {
        const int R0 = rt * 16, ch = R0 >> 7, s20 = R0 & 127;
        bf16x8 a[2];
#pragma unroll
        for (int kk = 0; kk < 2; ++kk) a[kk] = *(const bf16x8*)(UP + (size_t)(R0 + fr) * 64 + 32 * kk + 8 * g);
        f32x4 d[8];
#pragma unroll
        for (int nt = 0; nt < 8; ++nt) { d[nt] = (f32x4){0.f, 0.f, 0.f, 0.f};
#pragma unroll
            for (int kk = 0; kk < 2; ++kk) d[nt] = MFMA16(a[kk], bfr[nt][kk], d[nt]); }
#pragma unroll
        for (int nt = 0; nt < 4; ++nt) { const int k1 = 16 * nt + fr; float pr[4], pi[4];
#pragma unroll
            for (int r = 0; r < 4; ++r) { const int s2 = s20 + 4 * g + r; float sn, cs; sincospif((float)(s2 * k1) * (1.0f / 4096.0f), &sn, &cs);
                const float yr = d[nt][r], yi = d[nt + 4][r]; pr[r] = yr * cs + yi * sn; pi[r] = yi * cs - yr * sn; }
            bf16* dst = YB + (size_t)(ch * 64 + k1) * 256 + s20 + 4 * g;
            u32x2 w; w.x = pk2(pr[0], pr[1]); w.y = pk2(pr[2], pr[3]); *(u32x2*)dst = w;
            w.x = pk2(pi[0], pi[1]); w.y = pk2(pi[2], pi[3]); *(u32x2*)(dst + 128) = w; }
    }
}
__device__ __forceinline__ void f3_phase(const Args& A, unsigned char* lds) {
    const int tid = threadIdx.x, lane = tid & 63, wid = tid >> 6, fr = lane & 15, g = lane >> 4;
    const bf16* YB = (const bf16*)(A.ws + WS_YB); const bf16* BT3 = (const bf16*)(A.ws + WS_BT3); bf16* VB = (bf16*)(A.ws + WS_VB);
    constexpr int RS = 528;
    for (int i = 0; i < 16; ++i) { const int p = tid + 512 * i, row = p >> 5, c16 = p & 31; *(u32x4*)(lds + row * RS + c16 * 16) = *(const u32x4*)(BT3 + row * 256 + c16 * 8); }
    __syncthreads();
    for (int blk = blockIdx.x; blk < 256; blk += gridDim.x) {
        const int rt = blk * 8 + wid, k1 = rt >> 5, ch0 = (rt & 31) * 16;
        const bf16* ap = YB + (size_t)((ch0 + fr) * 64 + k1) * 256 + 8 * g;
        bf16x8 a[8];
#pragma unroll
        for (int kk = 0; kk < 8; ++kk) a[kk] = *(const bf16x8*)(ap + 32 * kk);
        const int grp = ch0 >> 7, cb = (ch0 & 127) + 4 * g;
#pragma unroll 4
        for (int nt = 0; nt < 16; ++nt) { f32x4 d = (f32x4){0.f, 0.f, 0.f, 0.f};
#pragma unroll
            for (int kk = 0; kk < 8; ++kk) { const bf16x8 b = *(const bf16x8*)(lds + (16 * nt + fr) * RS + (32 * kk + 8 * g) * 2); d = MFMA16(a[kk], b, d); }
            const int jc = 16 * nt + fr, k2 = jc & 127, im = jc >> 7, sp = k1 + 64 * k2;
            u32x2 w; w.x = pk2(d[0], d[1]); w.y = pk2(d[2], d[3]); *(u32x2*)(VB + (size_t)sp * 1024 + grp * 256 + im * 128 + cb) = w; }
    }
    __syncthreads();
}
__device__ __forceinline__ void f4_phase(const Args& A, unsigned char* lds) {
    const int tid = threadIdx.x, lane = tid & 63, wid = tid >> 6, fr = lane & 15, g = lane >> 4;
    const bf16* VB = (const bf16*)(A.ws + WS_VB); const bf16* WCS = (const bf16*)(A.ws + WS_WCS); bf16* MIX = (bf16*)(A.ws + WS_MIX);
    const float* SSQA = (const float*)(A.ws + WS_SSQA); float* RSA = (float*)(A.ws + WS_RSA);
    float* P = (float*)lds;
    const int g4 = wid & 3, half = wid >> 2;
    for (int blk = blockIdx.x; blk < 256; blk += gridDim.x) {
        const int sp = blk * 32 + half * 16 + fr;
        bf16x8 b[8];
#pragma unroll
        for (int kk = 0; kk < 8; ++kk) b[kk] = *(const bf16x8*)(VB + (size_t)sp * 1024 + g4 * 256 + 32 * kk + 8 * g);
        f32x4 o[8]; float sq = 0.f;
#pragma unroll
        for (int dt = 0; dt < 8; ++dt) { o[dt] = (f32x4){0.f, 0.f, 0.f, 0.f};
#pragma unroll
            for (int kk = 0; kk < 8; ++kk) { const bf16x8 a = *(const bf16x8*)(WCS + (size_t)(g4 * 128 + 16 * dt + fr) * 256 + 32 * kk + 8 * g); o[dt] = MFMA16(a, b[kk], o[dt]); }
            sq += (o[dt][0] * o[dt][0] + o[dt][1] * o[dt][1]) + (o[dt][2] * o[dt][2] + o[dt][3] * o[dt][3]); }
        sq += __shfl_xor(sq, 16); sq += __shfl_xor(sq, 32);
        if (g == 0) P[(half * 16 + fr) * 4 + g4] = sq;
        __syncthreads();
        const float* pp = P + (half * 16 + fr) * 4; const float tot = (pp[0] + pp[1]) + (pp[2] + pp[3]);
        const float rsf = 1.0f / sqrtf(tot * (1.0f / 512.0f) + RMS_EPS);
        float sa = 0.f;
#pragma unroll
        for (int h = 0; h < 12; ++h) sa += SSQA[(size_t)sp * 12 + h];
        const float rsa = 1.0f / sqrtf(sa * (1.0f / 1536.0f) + RMS_EPS);
        const float sc = rsf / rsa;
#pragma unroll
        for (int dt = 0; dt < 8; ++dt) { u32x2 w; w.x = pk2(o[dt][0] * sc, o[dt][1] * sc); w.y = pk2(o[dt][2] * sc, o[dt][3] * sc); *(u32x2*)(MIX + (size_t)sp * DM + NQ + g4 * 128 + 16 * dt + 4 * g) = w; }
        if (g4 == 0 && g == 0) RSA[sp] = rsa;
        __syncthreads();
    }
}
__device__ __forceinline__ void fixup_phase(const Args& A) {
    const float* edge = (const float*)(A.ws + WS_EDGE); const float* dww = A.in[10]; bf16* ACT = (bf16*)(A.ws + WS_ACT);
    const int gt = blockIdx.x * NTHREADS + threadIdx.x, NGT = gridDim.x * NTHREADS;
    for (int i = gt; i < 64 * (DFF / 4); i += NGT) { const int pe = i / (DFF / 4), c = (i % (DFF / 4)) * 4, pm = pe >> 1, e = pe & 1;
        const float* eb = edge + (size_t)(pe * 3) * DFF + c;
        f32x4 gp = *(const f32x4*)eb; const f32x4 V = *(const f32x4*)(eb + DFF);
        if (e == 0 && pm > 0) { const f32x4 G = *(const f32x4*)(edge + (size_t)(((pm - 1) * 2 + 1) * 3 + 2) * DFF + c); gp += *(const f32x4*)(dww + c) * G; }
        if (e == 1 && pm < 31) { const f32x4 G = *(const f32x4*)(edge + (size_t)(((pm + 1) * 2 + 0) * 3 + 2) * DFF + c); gp += *(const f32x4*)(dww + 2 * DFF + c) * G; }
        const pg8::f32x2 g0 = pg8::gelu_pk((pg8::f32x2){gp[0], gp[1]}), g1 = pg8::gelu_pk((pg8::f32x2){gp[2], gp[3]});
        const int row = 256 * pm + (e ? 255 : 0);
        u32x2 w; w.x = pk2(g0.x * V[0], g0.y * V[1]); w.y = pk2(g1.x * V[2], g1.y * V[3]); *(u32x2*)(ACT + (size_t)row * DFF + c) = w; }
}
__device__ __forceinline__ void final_phase(const Args& A) {
    const int tid = threadIdx.x, lane = tid & 63, wave = tid >> 6; const int gw = blockIdx.x * NWAVES + wave, NGW = gridDim.x * NWAVES;
    const float* SSQ2 = (const float*)(A.ws + WS_SSQ2); const float* ng = A.in[13];
    for (int m = gw; m < SEQ; m += NGW) {
        const f32x4 a = *(const f32x4*)(SSQ2 + (size_t)m * 8), b = *(const f32x4*)(SSQ2 + (size_t)m * 8 + 4);
        const float t = ((a[0] + a[1]) + (a[2] + a[3])) + ((b[0] + b[1]) + (b[2] + b[3])); const float rs = 1.0f / sqrtf(t * (1.0f / DM) + RMS_EPS);
        f32x4* xr = (f32x4*)(A.out + (size_t)m * DM) + lane; const f32x4* gr = (const f32x4*)ng + lane;
#pragma unroll
        for (int j = 0; j < 8; ++j) { const f32x4 v = xr[64 * j]; xr[64 * j] = v * rs * gr[64 * j]; }
    }
}

typedef __attribute__((address_space(1))) unsigned gu32;
#define RLX_AGENT __ATOMIC_RELAXED, __HIP_MEMORY_SCOPE_AGENT
#define XB_TMO      128
#define XB_XCNT(j)  (256  + 64 * (j))
#define XB_XSUB(j)  (1280 + 64 * (j))
#define XB_XGEN(j)  (2304 + 64 * (j))
#define XB_TOP      3328
#define XB_TOPGEN   3392
#define XCD_BAR_WORDS 3456
#define XB_SPIN_CAP (1u << 18)

__device__ __forceinline__ unsigned xb_ld(unsigned* p)              { return __hip_atomic_load(p, __ATOMIC_RELAXED, __HIP_MEMORY_SCOPE_AGENT); }
__device__ __forceinline__ unsigned xb_add(unsigned* p, unsigned v) { return __hip_atomic_fetch_add(p, v, __ATOMIC_RELAXED, __HIP_MEMORY_SCOPE_AGENT); }
__device__ __forceinline__ unsigned xb_xcc_id() { return (unsigned)__builtin_amdgcn_s_getreg((3 << 11) | 20) & 0xFu; }
#define XB_SPIN(cond, bar) do { unsigned _sp = 0; while (cond) { __builtin_amdgcn_s_sleep(1); \
    if ((++_sp & 255u) == 0u) { if (xb_ld(&(bar)[XB_TMO])) break; if (_sp > XB_SPIN_CAP) { atomicAdd(&(bar)[XB_TMO], 1u); break; } } } } while (0)

struct XcdBarrier {
    unsigned* bar; unsigned x;
    volatile LAS unsigned* st;
};

__device__ __forceinline__ XcdBarrier xcd_barrier_post(unsigned* bar, volatile LAS unsigned* st) {
    XcdBarrier b; b.bar = bar; b.x = xb_xcc_id(); b.st = st;
    if (threadIdx.x == 0) (void)xb_add(&bar[XB_XCNT(b.x)], 1u);
    return b;
}
__device__ __forceinline__ void xcd_barrier_complete(unsigned* bar, unsigned x, unsigned& nloc, unsigned& nx) {
    const unsigned G = gridDim.x * gridDim.y * gridDim.z;
    unsigned sum, cnt, mine, sp = 0u;
    for (;;) {
        sum = 0u; cnt = 0u; mine = 0u;
#pragma unroll
        for (unsigned j = 0; j < 16; ++j) { const unsigned c = xb_ld(&bar[XB_XCNT(j)]); sum += c; cnt += (c > 0u) ? 1u : 0u; mine = (j == x) ? c : mine; }
        if (sum == G) break;
        __builtin_amdgcn_s_sleep(1);
        if ((++sp & 255u) == 0u) { if (xb_ld(&bar[XB_TMO])) break; if (sp > XB_SPIN_CAP) { atomicAdd(&bar[XB_TMO], 1u); break; } }
    }
    nloc = mine > 0u ? mine : 1u; nx = cnt > 0u ? cnt : 1u;
}

__device__ __forceinline__ void xcd_barrier(const XcdBarrier& b) {
    asm volatile("s_waitcnt vmcnt(0)" ::: "memory");
    __syncthreads();
    if (threadIdx.x == 0) {
        unsigned* bar = b.bar;
        __builtin_amdgcn_s_waitcnt(0);
        unsigned nloc = b.st[0], nx = b.st[1];
        if (nloc == 0u) { xcd_barrier_complete(bar, b.x, nloc, nx); b.st[0] = nloc; b.st[1] = nx; }
        const unsigned old = xb_add(&bar[XB_XSUB(b.x)], 1u);
        const unsigned gen = old / nloc;
        if (old + 1u == (gen + 1u) * nloc) {
            __builtin_amdgcn_fence(__ATOMIC_RELEASE, "agent");
            asm volatile("s_waitcnt vmcnt(0)" ::: "memory");
            const unsigned og = xb_add(&bar[XB_TOP], 1u);
            const unsigned tg = og / nx;
            if (og + 1u == (tg + 1u) * nx) xb_add(&bar[XB_TOPGEN], 1u);
            else XB_SPIN(xb_ld(&bar[XB_TOPGEN]) == tg, bar);
            __builtin_amdgcn_fence(__ATOMIC_ACQUIRE, "agent");
            xb_add(&bar[XB_XGEN(b.x)], 1u);
            asm volatile("s_waitcnt vmcnt(0)" ::: "memory");
        } else {
            XB_SPIN(xb_ld(&bar[XB_XGEN(b.x)]) == gen, bar);
            __builtin_amdgcn_fence(__ATOMIC_ACQUIRE, "agent");
            asm volatile("s_waitcnt vmcnt(0)" ::: "memory");
        }
    }
    __syncthreads();
}

constexpr int NPHASE = 10;
__global__ void __launch_bounds__(NTHREADS, 2) fwd_mega(Args A) {
    extern __shared__ __attribute__((aligned(16))) unsigned char lds[];
    LAS unsigned char* ldsl = (LAS unsigned char*)lds;
    cg::grid_group grid = cg::this_grid();
    const int lo = A.ph_lo, hi = A.ph_hi;
    volatile LAS unsigned* MISC = (volatile LAS unsigned*)(ldsl + LDS_BYTES - 64);
    if (threadIdx.x < 16) MISC[threadIdx.x] = 0u;
    __syncthreads();
    XcdBarrier bar; bar.bar = (unsigned*)(A.ws + WS_CTL); bar.x = 0; bar.st = nullptr;
    if (hi - lo > 1) bar = xcd_barrier_post((unsigned*)(A.ws + WS_CTL), MISC + 8);
    if (hi > 1000) grid.sync();
#ifndef ONLY
#define ONLY -1
#endif
#define IN(k) ((ONLY < 0 || ONLY == (k)) && lo <= (k) && (k) < hi)
#ifndef REP_MASK
#define REP_MASK 0
#endif
#define REP(k) (((REP_MASK) >> (k)) & 1)
#define SEAM(k) do { if (IN(k) && IN((k) + 1)) xcd_barrier(bar); } while (0)
    unsigned char* ws = A.ws;
    const bf16* XB = (const bf16*)(ws + WS_XB); const float* RS1 = (const float*)(ws + WS_RS1);
    if (IN(0)) { p0_prologue(A, lds); if (REP(0)) { __syncthreads(); p0_prologue(A, lds); } } SEAM(0);
    if (IN(1)) {
        { pg8::Gemm gm{XB, (const bf16*)(ws + WS_WIN), SEQ, 2048, DM, 0}; pg8::StaticOrder S; S.init(SEQ, 2048, gridDim.x, blockIdx.x);
          pg8::EpiQK E{(bf16*)(ws + WS_Q), (bf16*)(ws + WS_K), RS1, 0.08838834764831845f * 1.4426950408889634f};
          pg8::gemm_phase<pg8::EpiQK, pg8::StaticOrder, true, true>(ldsl, gm, S, E); }
        { pg8::Gemm gm{(const bf16*)(ws + WS_WIN) + (size_t)2048 * DM, XB, 512, SEQ, DM, 0}; pg8::StaticOrder S; S.init(512, SEQ, gridDim.x, blockIdx.x);
          pg8::EpiVT E{(bf16*)(ws + WS_VT), RS1};
          pg8::gemm_phase<pg8::EpiVT, pg8::StaticOrder, true, true>(ldsl, gm, S, E); }
        { pg8::Gemm gm{(const bf16*)(ws + WS_WIN) + (size_t)2560 * DM, XB, 512, SEQ, DM, 1}; pg8::StaticOrder S; S.init(512, SEQ, gridDim.x, (int)((blockIdx.x + gridDim.x - 64) % gridDim.x));
          pg8::EpiUP E{(bf16*)(ws + WS_UP), RS1};
          pg8::gemm_phase<pg8::EpiUP, pg8::StaticOrder, true, true>(ldsl, gm, S, E); }
        { const int nh = (gridDim.x > 128) ? (int)gridDim.x - 128 : (int)gridDim.x, first = (int)gridDim.x - nh;
          if ((int)blockIdx.x >= first) { __syncthreads(); p0_weights(A, lds, 1, ((int)blockIdx.x - first) * NWAVES + (int)(threadIdx.x >> 6), nh * NWAVES); __syncthreads(); } }
    } SEAM(1);
    if (IN(2)) { attn_phase(A, lds); if (REP(10)) { __syncthreads(); attn_phase(A, lds); } f1_phase(A); if (REP(11)) f1_phase(A); } SEAM(2);
    if (IN(3)) { f3_phase(A, lds); if (REP(3)) f3_phase(A, lds); } SEAM(3);
    if (IN(4)) { f4_phase(A, lds); if (REP(4)) f4_phase(A, lds); } SEAM(4);
    if (IN(5)) {
        pg8::Gemm gm{(const bf16*)(ws + WS_MIX), (const bf16*)(ws + WS_WOUT), SEQ, DM, DM, 0}; pg8::StaticOrder S; S.init(SEQ, DM, gridDim.x, blockIdx.x);
        pg8::EpiRes E{A.in[0], A.out, (bf16*)(ws + WS_X1B), (const float*)(ws + WS_RSA), (float*)(ws + WS_SSQ1), ldsl + SCR_OFF};
        pg8::gemm_phase<pg8::EpiRes, pg8::StaticOrder, true, true>(ldsl, gm, S, E);
    } SEAM(5);
    if (IN(6)) {
        pg8::Gemm gm{(const bf16*)(ws + WS_X1B), (const bf16*)(ws + WS_WUP), SEQ, NUP, DM, 0}; pg8::StaticOrder S; S.init(SEQ, NUP, gridDim.x, blockIdx.x);
        pg8::EpiUp E{(bf16*)(ws + WS_ACT), (const float*)(ws + WS_SSQ1), A.in[10], A.in[11], (float*)(ws + WS_EDGE), ldsl + SCR_OFF};
        pg8::gemm_phase<pg8::EpiUp, pg8::StaticOrder, true, true>(ldsl, gm, S, E);
        if (REP(6)) pg8::gemm_phase<pg8::EpiUp, pg8::StaticOrder, true, true>(ldsl, gm, S, E);
    } SEAM(6);
    if (IN(7)) { fixup_phase(A); } SEAM(7);
    if (IN(8)) {
        pg8::Gemm gm{(const bf16*)(ws + WS_ACT), (const bf16*)(ws + WS_WDOWN), SEQ, DM, DFF, 0}; pg8::StaticOrder S; S.init(SEQ, DM, gridDim.x, blockIdx.x);
        pg8::EpiRes E{A.out, A.out, nullptr, nullptr, (float*)(ws + WS_SSQ2), ldsl + SCR_OFF};
        pg8::gemm_phase<pg8::EpiRes, pg8::StaticOrder, true, true>(ldsl, gm, S, E);
    } SEAM(8);
    if (IN(9)) { final_phase(A); }
#undef IN
#undef SEAM
}

#ifndef MK_PER_PHASE
#define MK_PER_PHASE 0
#endif
extern "C" void kernel_launch(void* const* d_in, const int* in_sizes, int n_in, void* d_out, int out_size, void* d_ws, size_t ws_size, hipStream_t stream) {
    static int grid = 0;
    if (grid == 0) {
        if (n_in != 14 || out_size != SEQ * DM || ws_size < WS_END) { fprintf(stderr, "kernel_launch: unexpected shapes (n_in %d out %d ws %zu)\n", n_in, out_size, ws_size); grid = -1; return; }
        int dev = 0, cus = 0, per_cu = 0;
        (void)hipGetDevice(&dev); (void)hipDeviceGetAttribute(&cus, hipDeviceAttributeMultiprocessorCount, dev);
        (void)hipFuncSetAttribute((const void*)fwd_mega, hipFuncAttributeMaxDynamicSharedMemorySize, LDS_BYTES);
        if (hipOccupancyMaxActiveBlocksPerMultiprocessor(&per_cu, (const void*)fwd_mega, NTHREADS, LDS_BYTES) != hipSuccess || per_cu < 1) per_cu = 1;
        (void)hipGetLastError();
        grid = cus * 1;
        if (grid <= 0) grid = 256;
    }
    if (grid < 0) return;
    (void)hipMemsetAsync((unsigned char*)d_ws + WS_CTL, 0, CTL_BYTES, stream);
    Args a{};
    for (int i = 0; i < 14; ++i) a.in[i] = (const float*)d_in[i];
    a.out = (float*)d_out; a.ws = (unsigned char*)d_ws;
#if MK_PER_PHASE
    for (int p = 0; p < NPHASE; ++p) { a.ph_lo = p; a.ph_hi = p + 1; hipLaunchKernelGGL(fwd_mega, dim3(grid), dim3(NTHREADS), LDS_BYTES, stream, a); }
#else
    a.ph_lo = 0; a.ph_hi = NPHASE;
    void* args[] = {&a};
    hipError_t e = hipLaunchCooperativeKernel((const void*)fwd_mega, dim3(grid), dim3(NTHREADS), args, LDS_BYTES, stream);
    if (e != hipSuccess) fprintf(stderr, "cooperative launch failed: %s (grid %d)\n", hipGetErrorString(e), grid);
#endif
}
```
